# Optimizing an MI355X kernel written in HIP

```python
import jax, jax.numpy as jnp
from jax import lax
import numpy as np

D_MODEL = 2048
BATCH = 1
SEQ = 8192
DEPTH = 4

N_BRANCH = 4
BRANCH_W = D_MODEL // N_BRANCH
GROUP_DIM = 128
N_GROUPS = BRANCH_W // GROUP_DIM
CHUNK = 128
CONV_W = 4
LRU_C = 8.0
FFN_HIDDEN = -(-8 * D_MODEL // (3 * 256)) * 256
IN_W = 11 * BRANCH_W + 2 * N_GROUPS
EPS = 1e-6

kernel_name = "hybrid_gated_gmlp_rglru_mlstm_stickbreak"


def rms_norm(x, g):
    xf = x.astype(jnp.float32)
    y = xf * lax.rsqrt(jnp.mean(xf * xf, axis=-1, keepdims=True) + EPS)
    return (y * g.astype(jnp.float32)).astype(x.dtype)


def causal_conv(x, w, b):
    s = x.shape[1]
    xp = jnp.pad(x, ((0, 0), (CONV_W - 1, 0), (0, 0)))
    return sum(xp[:, k:k + s] * w[k] for k in range(CONV_W)) + b


def gmlp_mixer(u_pre, v_pre, g_v, w_s, b_s):
    u = jax.nn.gelu(u_pre)
    v = rms_norm(jax.nn.gelu(v_pre), g_v)
    b, s, _ = v.shape
    nc = s // CHUNK
    vr = v.reshape(b, nc, CHUNK, N_GROUPS, GROUP_DIM)
    tri = jnp.tril(jnp.ones((CHUNK, CHUNK), dtype=bool))
    ws = jnp.where(tri, w_s, 0.0)
    sp = jnp.einsum("gtp,bnpgc->bntgc", ws, vr) + b_s.T[:, :, None]
    return u * sp.reshape(b, s, BRANCH_W)


def _lru_combine(left, right):
    a_l, b_l = left
    a_r, b_r = right
    return a_l * a_r, a_r * b_l + b_r


def rglru_mixer(x_pre, gate_pre, conv_w, conv_b, w_r, b_r, w_i, b_i, lam):
    xc = causal_conv(x_pre, conv_w, conv_b)
    b, s, _ = xc.shape
    xg = xc.reshape(b, s, N_GROUPS, GROUP_DIM)
    r = jax.nn.sigmoid(jnp.einsum("bsgc,gcd->bsgd", xg, w_r).reshape(b, s, BRANCH_W) + b_r)
    i = jax.nn.sigmoid(jnp.einsum("bsgc,gcd->bsgd", xg, w_i).reshape(b, s, BRANCH_W) + b_i)
    log_a = LRU_C * r.astype(jnp.float32) * jax.nn.log_sigmoid(lam.astype(jnp.float32))
    a = jnp.exp(log_a)
    bx = jnp.sqrt(-jnp.expm1(2.0 * log_a)) * (i * xc).astype(jnp.float32)
    _, h = lax.associative_scan(_lru_combine, (a, bx), axis=1)
    return h.astype(x_pre.dtype) * jax.nn.gelu(gate_pre)


def mlstm_mixer(q_pre, k_pre, v_pre, o_pre, i_pre, f_pre, conv_w, conv_b, b_i, b_f, g_h):
    qk = jax.nn.silu(causal_conv(jnp.concatenate([q_pre, k_pre], axis=-1), conv_w, conv_b))
    q, k = jnp.split(qk, 2, axis=-1)
    b, s, _ = q.shape
    nc = s // CHUNK
    f32 = jnp.float32
    qh = q.reshape(b, s, N_GROUPS, GROUP_DIM).astype(f32)
    kh = k.reshape(b, s, N_GROUPS, GROUP_DIM).astype(f32) * (GROUP_DIM ** -0.5)
    vh = v_pre.reshape(b, s, N_GROUPS, GROUP_DIM).astype(f32)
    ig = (i_pre + b_i).astype(f32)
    lf = jax.nn.log_sigmoid((f_pre + b_f).astype(f32))

    def to_chunks(t):
        return jnp.moveaxis(t.reshape((b, nc, CHUNK) + t.shape[2:]), 1, 0)

    tri = jnp.tril(jnp.ones((CHUNK, CHUNK), dtype=bool))

    def step(carry, inp):
        c_st, n_st, m_st = carry
        qc, kc, vc, ic, fc = inp
        ic = ic.transpose(0, 2, 1)
        bc = jnp.cumsum(fc.transpose(0, 2, 1), axis=-1)
        dmat = jnp.where(tri, bc[..., :, None] - bc[..., None, :] + ic[..., None, :], -jnp.inf)
        m_inter = bc + m_st[..., None]
        m_t = jnp.maximum(m_inter, jnp.max(dmat, axis=-1))
        p = jnp.einsum("bthd,bshd->bhts", qc, kc) * jnp.exp(dmat - m_t[..., None])
        sc = jnp.exp(m_inter - m_t)
        num = jnp.einsum("bhts,bshd->bhtd", p, vc) + sc[..., None] * jnp.einsum("bhvk,bthk->bhtv", c_st, qc)
        den = jnp.sum(p, axis=-1) + sc * jnp.einsum("bhk,bthk->bht", n_st, qc)
        h = num / jnp.maximum(jnp.abs(den), jnp.exp(-m_t))[..., None]
        b_last = bc[..., -1]
        g = b_last[..., None] - bc + ic
        m_new = jnp.maximum(b_last + m_st, jnp.max(g, axis=-1))
        w = jnp.exp(g - m_new[..., None])
        decay = jnp.exp(b_last + m_st - m_new)
        c_new = decay[..., None, None] * c_st + jnp.einsum("bhs,bshv,bshk->bhvk", w, vc, kc)
        n_new = decay[..., None] * n_st + jnp.einsum("bhs,bshk->bhk", w, kc)
        return (c_new, n_new, m_new), h.transpose(0, 2, 1, 3)

    init = (jnp.zeros((b, N_GROUPS, GROUP_DIM, GROUP_DIM), f32),
            jnp.zeros((b, N_GROUPS, GROUP_DIM), f32),
            jnp.zeros((b, N_GROUPS), f32))
    _, hs = lax.scan(step, init, (to_chunks(qh), to_chunks(kh), to_chunks(vh), to_chunks(ig), to_chunks(lf)))
    h = jnp.moveaxis(hs, 0, 1).reshape(b, s, N_GROUPS, GROUP_DIM)
    h = rms_norm(h, g_h).reshape(b, s, BRANCH_W).astype(v_pre.dtype)
    return jax.nn.sigmoid(o_pre) * h


def stick_breaking_mixer(q_pre, k_pre, v_pre, g_q, g_k):
    b, s, _ = q_pre.shape
    f32 = jnp.float32
    q = rms_norm(q_pre.reshape(b, s, N_GROUPS, GROUP_DIM), g_q).astype(f32)
    k = rms_norm(k_pre.reshape(b, s, N_GROUPS, GROUP_DIM), g_k).astype(f32)
    v = v_pre.reshape(b, s, N_GROUPS, GROUP_DIM).astype(f32)
    nb = s // CHUNK
    qb = jnp.moveaxis(q.reshape(b, nb, CHUNK, N_GROUPS, GROUP_DIM), 1, 0)
    s_pos = jnp.arange(s)
    scale = GROUP_DIM ** -0.5

    def block(args):
        blk, qc = args
        z = jnp.einsum("bthd,bshd->bhts", qc, k) * scale
        t_pos = blk * CHUNK + jnp.arange(CHUNK)
        strict = s_pos[None, :] < t_pos[:, None]
        ln1m = jnp.where(strict, jax.nn.log_sigmoid(-z), 0.0)
        rem = lax.cumsum(ln1m, axis=3, reverse=True) - ln1m
        att = jnp.where(strict, jnp.exp(jax.nn.log_sigmoid(z) + rem), 0.0)
        return jnp.einsum("bhts,bshd->bthd", att, v)

    out = lax.map(block, (jnp.arange(nb), qb))
    return jnp.moveaxis(out, 0, 1).reshape(b, s, BRANCH_W).astype(v_pre.dtype)


def setup_inputs(seed: int = 0) -> dict:
    key = jax.random.key(seed)
    ks = jax.random.split(key, 32)
    f32 = jnp.float32
    L, W, G, GD, D, F = DEPTH, BRANCH_W, N_GROUPS, GROUP_DIM, D_MODEL, FFN_HIDDEN

    def nrm(k, shape, scale):
        return jax.random.normal(k, shape, f32) * scale

    def gain(k, shape):
        return 1.0 + 0.02 * jax.random.normal(k, shape, f32)

    a8 = jax.random.uniform(ks[12], (L, W), f32, 0.9, 0.999)
    a = a8 ** (1.0 / LRU_C)
    lam = jnp.log(a) - jnp.log1p(-a)
    return {
        "x": nrm(ks[0], (BATCH, SEQ, D), 1.0),
        "norm_mix": gain(ks[1], (L, D)),
        "w_in": nrm(ks[2], (L, D, IN_W), D ** -0.5),
        "gm_norm_v": gain(ks[3], (L, W)),
        "gm_w_s": nrm(ks[4], (L, G, CHUNK, CHUNK), 0.5 * CHUNK ** -0.5),
        "gm_b_s": 1.0 + 0.1 * jax.random.normal(ks[5], (L, G, CHUNK), f32),
        "lru_conv_w": nrm(ks[6], (L, CONV_W, W), CONV_W ** -0.5),
        "lru_conv_b": nrm(ks[7], (L, W), 0.01),
        "lru_w_r": nrm(ks[8], (L, G, GD, GD), GD ** -0.5),
        "lru_b_r": nrm(ks[9], (L, W), 0.01),
        "lru_w_i": nrm(ks[10], (L, G, GD, GD), GD ** -0.5),
        "lru_b_i": nrm(ks[11], (L, W), 0.01),
        "lru_lambda": lam,
        "ml_conv_w": nrm(ks[13], (L, CONV_W, 2 * W), CONV_W ** -0.5),
        "ml_conv_b": nrm(ks[14], (L, 2 * W), 0.01),
        "ml_b_i": -2.0 + nrm(ks[15], (L, G), 0.1),
        "ml_b_f": jnp.linspace(3.0, 6.0, G, dtype=f32)[None, :] + nrm(ks[16], (L, G), 0.1),
        "ml_norm_h": gain(ks[17], (L, G, GD)),
        "sb_norm_q": gain(ks[18], (L, GD)),
        "sb_norm_k": gain(ks[19], (L, GD)),
        "w_branch": nrm(ks[20], (L, N_BRANCH, W, D), W ** -0.5),
        "w_gate": nrm(ks[21], (L, N_BRANCH, D, D), D ** -0.5),
        "b_gate": nrm(ks[22], (L, N_BRANCH, D), 0.01),
        "w_out": nrm(ks[23], (L, D, D), D ** -0.5),
        "norm_ffn": gain(ks[24], (L, D)),
        "w_ffn_gate": nrm(ks[25], (L, D, F), D ** -0.5),
        "w_ffn_up": nrm(ks[26], (L, D, F), D ** -0.5),
        "w_ffn_down": nrm(ks[27], (L, F, D), F ** -0.5),
    }


def reference(x, norm_mix, w_in, gm_norm_v, gm_w_s, gm_b_s, lru_conv_w, lru_conv_b, lru_w_r, lru_b_r,
              lru_w_i, lru_b_i, lru_lambda, ml_conv_w, ml_conv_b, ml_b_i, ml_b_f, ml_norm_h, sb_norm_q,
              sb_norm_k, w_branch, w_gate, b_gate, w_out, norm_ffn, w_ffn_gate, w_ffn_up, w_ffn_down):
    sizes = (BRANCH_W,) * 8 + (N_GROUPS,) * 2 + (BRANCH_W,) * 3
    offsets = np.cumsum(sizes)[:-1].tolist()
    for l in range(DEPTH):
        xn = rms_norm(x, norm_mix[l])
        proj = xn @ w_in[l]
        (a_u, a_v, b_x, b_g, c_q, c_k, c_v, c_o, c_i, c_f, d_q, d_k, d_v) = jnp.split(proj, offsets, axis=-1)
        y_a = gmlp_mixer(a_u, a_v, gm_norm_v[l], gm_w_s[l], gm_b_s[l])
        y_b = rglru_mixer(b_x, b_g, lru_conv_w[l], lru_conv_b[l], lru_w_r[l], lru_b_r[l],
                          lru_w_i[l], lru_b_i[l], lru_lambda[l])
        y_c = mlstm_mixer(c_q, c_k, c_v, c_o, c_i, c_f, ml_conv_w[l], ml_conv_b[l],
                          ml_b_i[l], ml_b_f[l], ml_norm_h[l])
        y_d = stick_breaking_mixer(d_q, d_k, d_v, sb_norm_q[l], sb_norm_k[l])
        branches = (y_a, y_b, y_c, y_d)
        merged = sum(jax.nn.sigmoid(xn @ w_gate[l, g] + b_gate[l, g]) * (branches[g] @ w_branch[l, g])
                     for g in range(N_BRANCH))
        x = x + merged @ w_out[l]
        hn = rms_norm(x, norm_ffn[l])
        x = x + (jax.nn.silu(hn @ w_ffn_gate[l]) * (hn @ w_ffn_up[l])) @ w_ffn_down[l]
    return x
```

```cpp
#include <hip/hip_runtime.h>
#include <cstdio>
#include <cstdint>

#define LAS __attribute__((address_space(3)))
#define GAS __attribute__((address_space(1)))
typedef unsigned short bf16_t;
typedef short bf16x8 __attribute__((ext_vector_type(8)));
typedef short s16x4 __attribute__((ext_vector_type(4)));
typedef float f32x4 __attribute__((ext_vector_type(4)));
typedef float f32x2 __attribute__((ext_vector_type(2)));
typedef unsigned u32x4 __attribute__((ext_vector_type(4)));
typedef unsigned u32x2 __attribute__((ext_vector_type(2)));

constexpr int SEQ = 8192, DM = 2048, DEPTH = 4, BW = 512, GD = 128, NG = 4, FF = 5632, INW = 5640;
constexpr int NA = 14080;
constexpr int PROJ_LD = 5632;
constexpr int GATES_LD = 8192;
constexpr float EPS = 1e-6f;
constexpr int NWAVES = 8, NTHREADS = 512;
constexpr int LDS_BYTES = 160 * 1024;
constexpr int LDS_MISC = LDS_BYTES - 64;

enum { I_X = 0, I_NORM_MIX, I_W_IN, I_GM_NORM_V, I_GM_W_S, I_GM_B_S, I_LRU_CONV_W, I_LRU_CONV_B, I_LRU_W_R, I_LRU_B_R, I_LRU_W_I, I_LRU_B_I, I_LRU_LAMBDA,
       I_ML_CONV_W, I_ML_CONV_B, I_ML_B_I, I_ML_B_F, I_ML_NORM_H, I_SB_NORM_Q, I_SB_NORM_K, I_W_BRANCH, I_W_GATE, I_B_GATE, I_W_OUT, I_NORM_FFN,
       I_W_FFN_GATE, I_W_FFN_UP, I_W_FFN_DOWN, N_IN };

constexpr size_t MiB = 1u << 20;
constexpr size_t WS_CTL = 0;
constexpr size_t WS_STATS = 1 * MiB;
constexpr size_t WS_IFG = 3 * MiB;
constexpr size_t WS_LRU_AH = 3 * MiB + 512 * 1024;
constexpr size_t WS_SMALLW = 4 * MiB;
constexpr size_t WS_XB = 8 * MiB;
constexpr size_t WS_Y = 40 * MiB;
constexpr size_t WS_MERGED = 72 * MiB;
constexpr size_t WS_PROJ = 104 * MiB;
constexpr size_t WS_GATES = 192 * MiB;
constexpr size_t WS_H = WS_PROJ;
constexpr size_t WS_ML = 320 * MiB;
constexpr size_t WS_NAIVE = 352 * MiB;
constexpr size_t WS_W = 416 * MiB;
constexpr size_t WL_A = 0, WL_C = 55 * MiB, WL_D = 63 * MiB, WL_E = 71 * MiB, WL_F = 115 * MiB, WL_STRIDE = 137 * MiB;
constexpr size_t WS_END = WS_W + DEPTH * WL_STRIDE;

typedef __bf16 bf16x2_t __attribute__((ext_vector_type(2)));
__device__ __forceinline__ unsigned cvt_pk_bf16(float lo, float hi) { const f32x2 v = {lo, hi}; return __builtin_bit_cast(unsigned, __builtin_convertvector(v, bf16x2_t)); }
__device__ __forceinline__ bf16_t f2bf(float f) { unsigned u = __builtin_bit_cast(unsigned, f); return (bf16_t)((u + 0x7fffu + ((u >> 16) & 1u)) >> 16); }
__device__ __forceinline__ float bf2f(bf16_t b) { return __builtin_bit_cast(float, (unsigned)b << 16); }
__device__ __forceinline__ float bflo(unsigned w) { return __builtin_bit_cast(float, w << 16); }
__device__ __forceinline__ float bfhi(unsigned w) { return __builtin_bit_cast(float, w & 0xffff0000u); }
__device__ __forceinline__ float sigmoidf_(float x) { return __builtin_amdgcn_rcpf(1.0f + __builtin_amdgcn_exp2f(-1.4426950408889634f * x)); }
__device__ __forceinline__ float gelu_tanh(float x) { const float u = 0.7978845608028654f * (x + 0.044715f * x * x * x); return x * sigmoidf_(2.0f * u); }
__device__ __forceinline__ float softplusf_(float x) { return fmaxf(x, 0.f) + log1pf(__expf(-fabsf(x))); }
__device__ __forceinline__ float logsigf_(float x) { return -softplusf_(-x); }
__device__ __forceinline__ float wave_sum(float v) {
#pragma unroll
    for (int o = 1; o < 64; o <<= 1) v += __shfl_xor(v, o);
    return v;
}
#define LDS_WAIT() asm volatile("s_waitcnt lgkmcnt(0)" ::: "memory")
#define VM_WAIT() asm volatile("s_waitcnt vmcnt(0)" ::: "memory")
namespace pg8 {
#define PG8_LAS __attribute__((address_space(3)))
constexpr int BM = 256, BK = 64, HALF = 128, HTB = HALF * BK * 2  , STAGE_BYTES = 8 * HTB, NXCD = 8, WGM = 8;

__host__ __device__ __forceinline__ int lds_byte(int r, int c) { const int st = (r >> 4) * 2 + (c >> 5), rr = r & 15, cc = c & 31, ob = rr * 64 + cc * 2; return st * 1024 + (ob ^ (((ob >> 9) & 1) << 5)); }
__host__ __device__ __forceinline__ void stage_rc(int b, int& R, int& C) { const int st = b / 1024, sb = b % 1024, swz = sb ^ (((sb >> 9) & 1) << 5); R = (st >> 1) * 16 + swz / 64; C = (st & 1) * 32 + (swz % 64) / 2; }
__host__ __device__ __forceinline__ int perm32(int rho) { const int n = rho >> 4, i = rho & 15; return 8 * (i >> 2) + 4 * n + (i & 3); }

struct Unit { int pm, pn; };
struct Gemm { const bf16_t* A; const bf16_t* Bt; int M, N, K; };

struct StaticOrder {
    int nM, nN, nwg, G, c;
    __host__ __device__ void init(int M, int N, int G_, int c_) { nM = M / BM; nN = N / BM; nwg = nM * nN; G = G_; c = c_; }
    __host__ __device__ bool next(int i, Unit& u) const {
        const long L = (long)i * G + c; if (L >= nwg) return false;
        int wgid = (int)L; { const int q = nwg / NXCD, r = nwg % NXCD, xcd = wgid % NXCD, off = wgid / NXCD; wgid = (xcd < r ? xcd * (q + 1) : r * (q + 1) + (xcd - r) * q) + off; }
        const int nig = WGM * nN, gid = wgid / nig, fm = gid * WGM, gsz = (nM - fm) < WGM ? (nM - fm) : WGM;
        u.pm = fm + ((wgid % nig) % gsz); u.pn = (wgid % nig) / gsz; return true;
    }
};

template <class Epi, class Sched>
__device__ __forceinline__ void gemm_phase(PG8_LAS unsigned char* lds, const Gemm g, const Sched& S, const Epi& E) {
    int tid_ = threadIdx.x; asm volatile("" : "+v"(tid_));
    const int tid = tid_, wid = __builtin_amdgcn_readfirstlane(tid >> 6), lane = tid & 63, wr = wid >> 2, wc = wid & 3, fr = lane & 15, fq = lane >> 4;
    const int K = g.K, nt = K / BK;
    unsigned voffA[2], voffB[2];
#pragma unroll
    for (int i = 0; i < 2; ++i) { int R, C; stage_rc(tid * 16 + i * 8192, R, C); const int Rb = Epi::PERM ? ((R & ~31) + perm32(R & 31)) : R;
        voffA[i] = (unsigned)(R * K + C) * 2u; voffB[i] = (unsigned)(Rb * K + C) * 2u; }
    const size_t kstep = (size_t)(BK * 2);
    const size_t hstep = (size_t)HALF * K * 2;
    const size_t tstep = 2 * hstep;
    const unsigned ldsw = (unsigned)wid * 1024u;
    const int aoff = lds_byte(wr * 64 + fr, fq * 8), boff = lds_byte(wc * 32 + fr, fq * 8);
#define PG8_SA(b, h) (((b) * 2 + (h)) * HTB)
#define PG8_SB(b, h) ((4 + (b) * 2 + (h)) * HTB)
#define PG8_STAGE(bufoff, gbase, voff) do { _Pragma("unroll") for (int _i = 0; _i < 2; ++_i) \
        __builtin_amdgcn_global_load_lds((const unsigned*)((const char*)(gbase) + (voff)[_i]), (PG8_LAS unsigned*)(lds + (bufoff) + ldsw + _i * 8192), 16, 0, 0); } while (0)
#define PG8_LDA(dst, b, h) do { _Pragma("unroll") for (int m = 0; m < 4; ++m) _Pragma("unroll") for (int k = 0; k < 2; ++k) dst[m][k] = *(const PG8_LAS bf16x8*)(lds + PG8_SA(b, h) + aoff + m * 2048 + k * 1024); } while (0)
#define PG8_LDB(dst, b, h) do { _Pragma("unroll") for (int n = 0; n < 2; ++n) _Pragma("unroll") for (int k = 0; k < 2; ++k) dst[n][k] = *(const PG8_LAS bf16x8*)(lds + PG8_SB(b, h) + boff + n * 2048 + k * 1024); } while (0)
#define PG8_MMA(ai, bj, At, Bt) do { __builtin_amdgcn_s_setprio(1); _Pragma("unroll") for (int m = 0; m < 4; ++m) _Pragma("unroll") for (int n = 0; n < 2; ++n) _Pragma("unroll") for (int k = 0; k < 2; ++k) \
        acc[ai][bj][m][n] = __builtin_amdgcn_mfma_f32_16x16x32_bf16(Bt[n][k], At[m][k], acc[ai][bj][m][n], 0, 0, 0); __builtin_amdgcn_s_setprio(0); } while (0)
#define PG8_WAIT_V(n) asm volatile("s_waitcnt vmcnt(" #n ")" ::: "memory")
#define PG8_WAIT_L(n) asm volatile("s_waitcnt lgkmcnt(" #n ")" ::: "memory")
#define PG8_BAR __builtin_amdgcn_s_barrier()
#define PG8_SCHED __builtin_amdgcn_sched_barrier(0)
    Unit cur, nxt; int ui = 0;
    if (!S.next(0, cur)) return;
    f32x4 acc[2][2][4][2];
#pragma unroll
    for (int a = 0; a < 2; ++a)
#pragma unroll
        for (int b = 0; b < 2; ++b)
#pragma unroll
            for (int m = 0; m < 4; ++m)
#pragma unroll
                for (int n = 0; n < 2; ++n) acc[a][b][m][n] = (f32x4){0.f, 0.f, 0.f, 0.f};
    bf16x8 At[4][2], B0[2][2], B1[2][2];
    const char* cA = (const char*)g.A + (size_t)cur.pm * tstep; const char* cB = (const char*)g.Bt + (size_t)cur.pn * tstep;
    int cached_pm = -1;
    E.next(cur, 0, lds, wid, lane);
    PG8_STAGE(PG8_SB(0, 0), cB, voffB); PG8_STAGE(PG8_SB(0, 1), cB + hstep, voffB); PG8_STAGE(PG8_SA(0, 0), cA, voffA); PG8_STAGE(PG8_SA(0, 1), cA + hstep, voffA);
    if (wr == 1) PG8_BAR;
    PG8_WAIT_V(2); PG8_BAR;
    PG8_STAGE(PG8_SB(1, 0), cB + kstep, voffB); PG8_STAGE(PG8_SA(1, 0), cA + kstep, voffA); PG8_STAGE(PG8_SB(1, 1), cB + hstep + kstep, voffB);
    PG8_WAIT_V(6); PG8_BAR;
    for (;;) {
        const bool has_next = S.next(ui + 1, nxt);
        const char* nA = has_next ? (const char*)g.A + (size_t)nxt.pm * tstep : cA; const char* nB = has_next ? (const char*)g.Bt + (size_t)nxt.pn * tstep : cB;
        for (int t = 0; t < nt; t += 2) {
            const bool last = (t == nt - 2);
            const char* a1 = cA + (size_t)(t + 1) * kstep;
            const char* a2 = last ? nA : cA + (size_t)(t + 2) * kstep; const char* b2 = last ? nB : cB + (size_t)(t + 2) * kstep;
            const char* a3 = a2 + kstep; const char* b3 = b2 + kstep;
            PG8_LDB(B0, 0, 0); PG8_LDB(B1, 0, 1); PG8_SCHED; PG8_LDA(At, 0, 0); PG8_STAGE(PG8_SA(1, 1), a1 + hstep, voffA);
            PG8_WAIT_V(8); PG8_WAIT_L(0); PG8_BAR; PG8_MMA(0, 0, At, B0); PG8_MMA(0, 1, At, B1); PG8_BAR; PG8_SCHED;
            PG8_LDA(At, 0, 1); PG8_STAGE(PG8_SB(0, 0), b2, voffB); PG8_STAGE(PG8_SB(0, 1), b2 + hstep, voffB); PG8_STAGE(PG8_SA(0, 0), a2, voffA);
            PG8_WAIT_V(8); PG8_WAIT_L(0); PG8_BAR; PG8_MMA(1, 0, At, B0); PG8_MMA(1, 1, At, B1); PG8_BAR; PG8_SCHED;
            PG8_LDB(B0, 1, 0); PG8_LDB(B1, 1, 1); PG8_SCHED; PG8_LDA(At, 1, 0); PG8_STAGE(PG8_SA(0, 1), a2 + hstep, voffA);
            PG8_WAIT_V(8); PG8_WAIT_L(0); PG8_BAR; PG8_MMA(0, 0, At, B0); PG8_MMA(0, 1, At, B1); PG8_BAR; PG8_SCHED;
            PG8_LDA(At, 1, 1); PG8_STAGE(PG8_SB(1, 0), b3, voffB); PG8_STAGE(PG8_SB(1, 1), b3 + hstep, voffB); PG8_STAGE(PG8_SA(1, 0), a3, voffA);
            PG8_WAIT_V(8); PG8_WAIT_L(0); PG8_BAR; PG8_MMA(1, 0, At, B0); PG8_MMA(1, 1, At, B1); PG8_BAR; PG8_SCHED;
            if constexpr (Epi::FOLD) { if (!last && ((t + 2) & 7) == 0) {
                if (wr == 0) PG8_BAR; E.fold(acc, cur, ((t + 2) >> 3) - 1, wr, wc, fr, fq); PG8_SCHED; if (wr == 1) PG8_BAR; } }
        }
        if (wr == 0) PG8_BAR;
        E.prep(cur, cached_pm, lds, wid, lane);
        E(acc, cur, ui, lds, wid, wr, wc, fr, fq);
        if (has_next) E.next(nxt, ui + 1, lds, wid, lane);
#ifdef REP_EPI
        if constexpr (Epi::REPEAT == REP_EPI) { PG8_SCHED; E(acc, cur, ui, lds, wid, wr, wc, fr, fq); }
#endif
        if (!has_next) break;
#pragma unroll
        for (int a = 0; a < 2; ++a)
#pragma unroll
            for (int b = 0; b < 2; ++b)
#pragma unroll
                for (int m = 0; m < 4; ++m)
#pragma unroll
                    for (int n = 0; n < 2; ++n) acc[a][b][m][n] = (f32x4){0.f, 0.f, 0.f, 0.f};
        cur = nxt; cA = nA; cB = nB; ++ui;
        if (wr == 1) PG8_BAR;
    }
    PG8_WAIT_V(0);
    PG8_BAR;
#undef PG8_SA
#undef PG8_SB
#undef PG8_STAGE
#undef PG8_LDA
#undef PG8_LDB
#undef PG8_MMA
#undef PG8_WAIT_V
#undef PG8_WAIT_L
#undef PG8_BAR
#undef PG8_SCHED
}
}
#define XB_TMO      128
#define XB_XCNT(j)  (256  + 64 * (j))
#define XB_XSUB(j)  (1280 + 64 * (j))
#define XB_XGEN(j)  (2304 + 64 * (j))
#define XB_TOP      3328
#define XB_TOPGEN   3392
#define XCD_BAR_WORDS 3456
#define XB_SPIN_CAP (1u << 18)

__device__ __forceinline__ unsigned xb_ld(unsigned* p)              { return __hip_atomic_load(p, __ATOMIC_RELAXED, __HIP_MEMORY_SCOPE_AGENT); }
__device__ __forceinline__ unsigned xb_add(unsigned* p, unsigned v) { return __hip_atomic_fetch_add(p, v, __ATOMIC_RELAXED, __HIP_MEMORY_SCOPE_AGENT); }
__device__ __forceinline__ unsigned xb_xcc_id() { return (unsigned)__builtin_amdgcn_s_getreg((3 << 11) | 20) & 0xFu; }
#define XB_SPIN(cond, bar) do { unsigned _sp = 0; while (cond) { __builtin_amdgcn_s_sleep(1); \
    if ((++_sp & 255u) == 0u) { if (xb_ld(&(bar)[XB_TMO])) break; if (_sp > XB_SPIN_CAP) { atomicAdd(&(bar)[XB_TMO], 1u); break; } } } } while (0)

struct XcdBarrier {
    unsigned* bar; unsigned x;
    volatile LAS unsigned* st;
};

__device__ __forceinline__ XcdBarrier xcd_barrier_post(unsigned* bar, volatile LAS unsigned* st) {
    XcdBarrier b; b.bar = bar; b.x = xb_xcc_id(); b.st = st;
    if (threadIdx.x == 0) (void)xb_add(&bar[XB_XCNT(b.x)], 1u);
    return b;
}
__device__ __forceinline__ void xcd_barrier_complete(unsigned* bar, unsigned x, unsigned& nloc, unsigned& nx) {
    const unsigned G = gridDim.x * gridDim.y * gridDim.z;
    unsigned sum, cnt, mine, sp = 0u;
    for (;;) {
        sum = 0u; cnt = 0u; mine = 0u;
#pragma unroll
        for (unsigned j = 0; j < 16; ++j) { const unsigned c = xb_ld(&bar[XB_XCNT(j)]); sum += c; cnt += (c > 0u) ? 1u : 0u; mine = (j == x) ? c : mine; }
        if (sum == G) break;
        __builtin_amdgcn_s_sleep(1);
        if ((++sp & 255u) == 0u) { if (xb_ld(&bar[XB_TMO])) break; if (sp > XB_SPIN_CAP) { atomicAdd(&bar[XB_TMO], 1u); break; } }
    }
    nloc = mine > 0u ? mine : 1u; nx = cnt > 0u ? cnt : 1u;
}

__device__ __forceinline__ void xcd_barrier(const XcdBarrier& b) {
    asm volatile("s_waitcnt vmcnt(0)" ::: "memory");
    __syncthreads();
    if (threadIdx.x == 0) {
        unsigned* bar = b.bar;
        __builtin_amdgcn_s_waitcnt(0);
        unsigned nloc = b.st[0], nx = b.st[1];
        if (nloc == 0u) { xcd_barrier_complete(bar, b.x, nloc, nx); b.st[0] = nloc; b.st[1] = nx; }
        const unsigned old = xb_add(&bar[XB_XSUB(b.x)], 1u);
        const unsigned gen = old / nloc;
        if (old + 1u == (gen + 1u) * nloc) {
            __builtin_amdgcn_fence(__ATOMIC_RELEASE, "agent");
            asm volatile("s_waitcnt vmcnt(0)" ::: "memory");
            const unsigned og = xb_add(&bar[XB_TOP], 1u);
            const unsigned tg = og / nx;
            if (og + 1u == (tg + 1u) * nx) xb_add(&bar[XB_TOPGEN], 1u);
            else XB_SPIN(xb_ld(&bar[XB_TOPGEN]) == tg, bar);
            __builtin_amdgcn_fence(__ATOMIC_ACQUIRE, "agent");
            xb_add(&bar[XB_XGEN(b.x)], 1u);
            asm volatile("s_waitcnt vmcnt(0)" ::: "memory");
        } else {
            XB_SPIN(xb_ld(&bar[XB_XGEN(b.x)]) == gen, bar);
            __builtin_amdgcn_fence(__ATOMIC_ACQUIRE, "agent");
            asm volatile("s_waitcnt vmcnt(0)" ::: "memory");
        }
    }
    __syncthreads();
}
constexpr int EPI_RSTD = 131072, EPI_BIAS = 131072 + 4096;
__device__ __forceinline__ void rstd_prep(const float* stats, const pg8::Unit& u, int& cached_pm, LAS unsigned char* lds, int wid, int lane) {
    if (u.pm == cached_pm) return;
    cached_pm = u.pm;
    LAS float* tab = (LAS float*)(lds + EPI_RSTD + wid * 512); const int wr = wid >> 2;
#pragma unroll
    for (int q = 0; q < 2; ++q) { const int j = lane + 64 * q, row = u.pm * 256 + (j >> 6) * 128 + wr * 64 + (j & 63);
        const f32x4* p = (const f32x4*)(stats + (size_t)row * 32); f32x4 s = p[0];
#pragma unroll
        for (int i = 1; i < 8; ++i) s = s + p[i];
        tab[j] = rsqrtf(((s.x + s.y) + (s.z + s.w)) * (1.0f / (float)DM) + EPS); }
    LDS_WAIT();
}
__device__ __forceinline__ void load_rstd(LAS unsigned char* lds, int wid, int fr, float (&rs)[2][4]) {
    const LAS float* tab = (const LAS float*)(lds + EPI_RSTD + wid * 512);
#pragma unroll
    for (int ai = 0; ai < 2; ++ai)
#pragma unroll
        for (int m = 0; m < 4; ++m) rs[ai][m] = tab[ai * 64 + m * 16 + fr];
}
__device__ __forceinline__ u32x4 pack8(const f32x4 v0, const f32x4 v1) { u32x4 w; w.x = cvt_pk_bf16(v0[0], v0[1]); w.y = cvt_pk_bf16(v0[2], v0[3]); w.z = cvt_pk_bf16(v1[0], v1[1]); w.w = cvt_pk_bf16(v1[2], v1[3]); return w; }

struct EpiA {
    static constexpr bool PERM = true, FOLD = false; static constexpr int REPEAT = 1;
    const float* stats; bf16_t* proj; float* ifg; unsigned char* gates; const float* bgate;
    __device__ __forceinline__ void prep(const pg8::Unit& u, int& cached_pm, LAS unsigned char* lds, int wid, int lane) const { rstd_prep(stats, u, cached_pm, lds, wid, lane); }
    __device__ __forceinline__ void next(const pg8::Unit& u, int ui, LAS unsigned char* lds, int wid, int lane) const {
        if (u.pn >= 23 && wid < 4) { const int gi = u.pn - 23;
            __builtin_amdgcn_global_load_lds((const unsigned*)(bgate + (gi >> 3) * 2048 + (gi & 7) * 256 + wid * 64 + lane), (LAS unsigned*)(lds + EPI_BIAS + (ui & 1) * 1024 + wid * 256), 4, 0, 0); }
    }
    __device__ __forceinline__ void operator()(const f32x4 (&acc)[2][2][4][2], const pg8::Unit& u, int ui, LAS unsigned char* lds, int wid, int wr, int wc, int fr_, int fq_) const {
        int fr = fr_, fq = fq_; asm volatile("" : "+v"(fr), "+v"(fq));
        float rs[2][4]; load_rstd(lds, wid, fr, rs);
        const int row0 = u.pm * 256 + wr * 64 + fr;
        if (u.pn < 22) {
            const int col0 = u.pn * 256 + wc * 32 + 8 * fq;
#pragma unroll
            for (int ai = 0; ai < 2; ++ai)
#pragma unroll
                for (int m = 0; m < 4; ++m) { bf16_t* rowp = proj + (size_t)(row0 + ai * 128 + m * 16) * PROJ_LD + col0; const float r = rs[ai][m];
#pragma unroll
                    for (int bj = 0; bj < 2; ++bj) *(u32x4*)(rowp + bj * 128) = pack8(acc[ai][bj][m][0] * r, acc[ai][bj][m][1] * r); }
        } else if (u.pn == 22) {
            if (wc == 0 && fq == 0) {
#pragma unroll
                for (int ai = 0; ai < 2; ++ai)
#pragma unroll
                    for (int m = 0; m < 4; ++m) { float* p = ifg + (size_t)(row0 + ai * 128 + m * 16) * 8; const float r = rs[ai][m];
                        *(f32x4*)p = acc[ai][0][m][0] * r; *(f32x4*)(p + 4) = acc[ai][0][m][1] * r; }
            }
        } else {
            const int gi = u.pn - 23, g = gi >> 3, col0 = (gi & 7) * 256 + wc * 64 + 16 * fq;
            const LAS float* bl = (const LAS float*)(lds + EPI_BIAS + (ui & 1) * 1024) + wc * 64 + 16 * fq;
            f32x4 bv[2][2];
#pragma unroll
            for (int bj = 0; bj < 2; ++bj)
#pragma unroll
                for (int n = 0; n < 2; ++n) bv[bj][n] = *(const LAS f32x4*)(bl + 8 * bj + 4 * n);
#pragma unroll
            for (int ai = 0; ai < 2; ++ai)
#pragma unroll
                for (int m = 0; m < 4; ++m) { const float r = rs[ai][m]; u32x4 qw;
#pragma unroll
                    for (int bj = 0; bj < 2; ++bj)
#pragma unroll
                        for (int n = 0; n < 2; ++n) { const f32x4 v = acc[ai][bj][m][n] * r + bv[bj][n]; unsigned w = 0u;
                            w = __builtin_amdgcn_cvt_pk_u8_f32(sigmoidf_(v[0]) * 256.0f - 0.5f, 0, w); w = __builtin_amdgcn_cvt_pk_u8_f32(sigmoidf_(v[1]) * 256.0f - 0.5f, 1, w);
                            w = __builtin_amdgcn_cvt_pk_u8_f32(sigmoidf_(v[2]) * 256.0f - 0.5f, 2, w); w = __builtin_amdgcn_cvt_pk_u8_f32(sigmoidf_(v[3]) * 256.0f - 0.5f, 3, w);
                            qw[2 * bj + n] = w; }
                    *(u32x4*)(gates + (size_t)(row0 + ai * 128 + m * 16) * GATES_LD + g * 2048 + col0) = qw; }
        }
    }
};
struct EpiC {
    static constexpr bool PERM = true, FOLD = true; static constexpr int REPEAT = 0;
    const unsigned char* gates; bf16_t* merged;
    __device__ __forceinline__ void prep(const pg8::Unit&, int&, LAS unsigned char*, int, int) const {}
    __device__ __forceinline__ void next(const pg8::Unit&, int, LAS unsigned char*, int, int) const {}
    static __device__ __forceinline__ void unq(const u32x2 w, float (&x)[8]) {
        x[0] = (float)(w.x & 0xffu) + 0.5f; x[1] = (float)((w.x >> 8) & 0xffu) + 0.5f; x[2] = (float)((w.x >> 16) & 0xffu) + 0.5f; x[3] = (float)(w.x >> 24) + 0.5f;
        x[4] = (float)(w.y & 0xffu) + 0.5f; x[5] = (float)((w.y >> 8) & 0xffu) + 0.5f; x[6] = (float)((w.y >> 16) & 0xffu) + 0.5f; x[7] = (float)(w.y >> 24) + 0.5f; }
    __device__ __forceinline__ void fold(f32x4 (&acc)[2][2][4][2], const pg8::Unit& u, int g, int wr, int wc, int fr_, int fq_) const {
        int fr = fr_, fq = fq_; asm volatile("" : "+v"(fr), "+v"(fq));
        const unsigned off0 = (unsigned)(u.pm * 256 + wr * 64 + fr) * (unsigned)GATES_LD + (unsigned)(g * 2048 + u.pn * 256 + wc * 32 + 8 * fq);
        const unsigned char* gb = gates;
#pragma unroll
        for (int ai = 0; ai < 2; ++ai) {
#pragma unroll
            for (int m = 0; m < 4; ++m) { const unsigned off = off0 + (unsigned)(ai * 128 + m * 16) * (unsigned)GATES_LD;
#pragma unroll
                for (int bj = 0; bj < 2; ++bj) { float a[8], b[8]; unq(*(const u32x2*)(gb + off + bj * 128), a); unq(*(const u32x2*)(gb + off + 2048 + bj * 128), b);
#pragma unroll
                    for (int q = 0; q < 8; ++q) acc[ai][bj][m][q >> 2][q & 3] *= a[q] * __builtin_amdgcn_rcpf(b[q]); } }
            asm volatile("" ::: "memory"); }
    }
    __device__ __forceinline__ void operator()(const f32x4 (&acc)[2][2][4][2], const pg8::Unit& u, int, LAS unsigned char*, int, int wr, int wc, int fr_, int fq) const {
        int fr = fr_; asm volatile("" : "+v"(fr));
        const int row0 = u.pm * 256 + wr * 64 + fr, col0 = u.pn * 256 + wc * 32 + 8 * fq;
        const unsigned goff0 = (unsigned)row0 * (unsigned)GATES_LD + (unsigned)(3 * 2048 + col0), moff0 = (unsigned)row0 * (DM * 2u) + (unsigned)col0 * 2u;
        const unsigned char* gb = gates; char* mb = (char*)merged;
#pragma unroll
        for (int ai = 0; ai < 2; ++ai)
#pragma unroll
            for (int m = 0; m < 4; ++m) { const unsigned goff = goff0 + (unsigned)(ai * 128 + m * 16) * (unsigned)GATES_LD, moff = moff0 + (unsigned)(ai * 128 + m * 16) * (DM * 2u);
#pragma unroll
                for (int bj = 0; bj < 2; ++bj) { float a[8]; unq(*(const u32x2*)(gb + goff + bj * 128), a); f32x4 v0 = acc[ai][bj][m][0], v1 = acc[ai][bj][m][1];
#pragma unroll
                    for (int q = 0; q < 4; ++q) { v0[q] *= a[q] * (1.0f / 256.0f); v1[q] *= a[4 + q] * (1.0f / 256.0f); }
                    *(u32x4*)(mb + moff + bj * 256) = pack8(v0, v1); } }
    }
};
template <bool LAST> struct EpiD {
    static constexpr bool PERM = true, FOLD = false; static constexpr int REPEAT = 0;
    bf16_t* xb; float* stats_out; float* out; bf16_t* xdst;
    __device__ __forceinline__ void prep(const pg8::Unit&, int&, LAS unsigned char*, int, int) const {}
    __device__ __forceinline__ void next(const pg8::Unit&, int, LAS unsigned char*, int, int) const {}
    __device__ __forceinline__ void operator()(const f32x4 (&acc)[2][2][4][2], const pg8::Unit& u, int, LAS unsigned char*, int, int wr, int wc, int fr_, int fq) const {
        int fr = fr_; asm volatile("" : "+v"(fr));
        const int row0 = u.pm * 256 + wr * 64 + fr, col0 = u.pn * 256 + wc * 32 + 8 * fq;
#pragma unroll
        for (int ai = 0; ai < 2; ++ai) {
            u32x4 xo[4][2];
#pragma unroll
            for (int m = 0; m < 4; ++m)
#pragma unroll
                for (int bj = 0; bj < 2; ++bj) xo[m][bj] = *(const u32x4*)(xb + (size_t)(row0 + ai * 128 + m * 16) * DM + col0 + bj * 128);
#pragma unroll
            for (int m = 0; m < 4; ++m) { const int row = row0 + ai * 128 + m * 16; const size_t off = (size_t)row * DM + col0; float ss = 0.f;
#pragma unroll
                for (int bj = 0; bj < 2; ++bj) { const u32x4 xw = xo[m][bj];
                    f32x4 v0 = acc[ai][bj][m][0], v1 = acc[ai][bj][m][1];
                    v0[0] += bflo(xw.x); v0[1] += bfhi(xw.x); v0[2] += bflo(xw.y); v0[3] += bfhi(xw.y); v1[0] += bflo(xw.z); v1[1] += bfhi(xw.z); v1[2] += bflo(xw.w); v1[3] += bfhi(xw.w);
                    if (LAST) { *(f32x4*)(out + off + bj * 128) = v0; *(f32x4*)(out + off + bj * 128 + 4) = v1; }
                    else { const u32x4 pw = pack8(v0, v1); *(u32x4*)(xdst + off + bj * 128) = pw;
                        const float r0 = bflo(pw.x), r1 = bfhi(pw.x), r2 = bflo(pw.y), r3 = bfhi(pw.y), r4 = bflo(pw.z), r5 = bfhi(pw.z), r6 = bflo(pw.w), r7 = bfhi(pw.w);
                        ss += ((r0 * r0 + r1 * r1) + (r2 * r2 + r3 * r3)) + ((r4 * r4 + r5 * r5) + (r6 * r6 + r7 * r7)); } }
                if (!LAST) { ss += __shfl_xor(ss, 16); ss += __shfl_xor(ss, 32);
                    if (fq == 0) stats_out[(size_t)row * 32 + u.pn * 4 + wc] = ss; } }
            asm volatile("" ::: "memory"); }
    }
};
struct EpiE {
    static constexpr bool PERM = true, FOLD = false; static constexpr int REPEAT = 2;
    const float* stats; bf16_t* h;
    __device__ __forceinline__ void prep(const pg8::Unit& u, int& cached_pm, LAS unsigned char* lds, int wid, int lane) const { rstd_prep(stats, u, cached_pm, lds, wid, lane); }
    __device__ __forceinline__ void next(const pg8::Unit&, int, LAS unsigned char*, int, int) const {}
    __device__ __forceinline__ void operator()(const f32x4 (&acc)[2][2][4][2], const pg8::Unit& u, int, LAS unsigned char* lds, int wid, int wr, int wc, int fr_, int fq_) const {
        int fr = fr_, fq = fq_; asm volatile("" : "+v"(fr), "+v"(fq));
        float rs[2][4]; load_rstd(lds, wid, fr, rs);
        const int row0 = u.pm * 256 + wr * 64 + fr, col0 = u.pn * 128 + wc * 32 + 8 * fq;
#pragma unroll
        for (int ai = 0; ai < 2; ++ai)
#pragma unroll
            for (int m = 0; m < 4; ++m) { const float r = rs[ai][m]; f32x4 o[2];
#pragma unroll
                for (int n = 0; n < 2; ++n) { const f32x4 gv = acc[ai][0][m][n] * r, uv = acc[ai][1][m][n] * r;
#pragma unroll
                    for (int j = 0; j < 4; ++j) o[n][j] = gv[j] * sigmoidf_(gv[j]) * uv[j]; }
                *(u32x4*)(h + (size_t)(row0 + ai * 128 + m * 16) * FF + col0) = pack8(o[0], o[1]); }
    }
};
__device__ __forceinline__ void cvt_item(const float* W, int ldw, int k0, int c0, bf16_t* WT, size_t dld, int drow0, int dcol0, const float* gain, int nvalid, LAS float* scr, int lane, bool gateperm = false) {
    const int c4 = lane & 15, r4 = lane >> 4;
    f32x4 v[16];
#pragma unroll
    for (int i = 0; i < 16; ++i) v[i] = *(const GAS f32x4*)(W + (size_t)(k0 + 4 * i + r4) * ldw + c0 + 4 * c4);
    if (gain) {
#pragma unroll
        for (int i = 0; i < 16; ++i) v[i] = v[i] * gain[k0 + 4 * i + r4];
    }
#pragma unroll
    for (int i = 0; i < 16; ++i)
#pragma unroll
        for (int j = 0; j < 4; ++j) scr[(4 * c4 + j) * 65 + 4 * i + r4] = v[i][j];
    LDS_WAIT();
    const int c = lane & 7, ns = lane >> 3;
#pragma unroll
    for (int p = 0; p < 8; ++p) { const int n = 8 * p + ns; const LAS float* s = scr + n * 65 + 8 * c;
        u32x4 o; o.x = cvt_pk_bf16(s[0], s[1]); o.y = cvt_pk_bf16(s[2], s[3]); o.z = cvt_pk_bf16(s[4], s[5]); o.w = cvt_pk_bf16(s[6], s[7]);
        if (n >= nvalid) o = (u32x4){0u, 0u, 0u, 0u};
        const int nr = gateperm ? 128 * ((n >> 3) & 1) + 8 * (n >> 4) + (n & 7) : n;
        *(GAS u32x4*)(WT + (size_t)(drow0 + nr) * dld + dcol0 + k0 + 8 * c) = o; }
    LDS_WAIT();
}
constexpr int CV_J0 = 2048, CV_J1 = 768, CV_J2 = 32, CV_JG = 1024, CV_JC = 256, CV_JD = 1024, CV_JE = 2816, CV_JF = 2816;
constexpr int CV_PER_LAYER = CV_J0 + CV_J1 + CV_J2 + 4 * CV_JG + 4 * CV_JC + CV_JD + 2 * CV_JE + CV_JF;
struct Args { const float* in[N_IN]; float* out; unsigned char* ws; int ph_lo, ph_hi, flags, pad; };
typedef Args Ptrs;
__device__ __forceinline__ void cvt_dispatch(const Ptrs& P, int it, LAS float* scr, int lane) {
    const int l = it / CV_PER_LAYER; int r = it % CV_PER_LAYER;
    unsigned char* wl = P.ws + WS_W + (size_t)l * WL_STRIDE;
    bf16_t* WA = (bf16_t*)(wl + WL_A); bf16_t* WC = (bf16_t*)(wl + WL_C); bf16_t* WD = (bf16_t*)(wl + WL_D); bf16_t* WE = (bf16_t*)(wl + WL_E); bf16_t* WF = (bf16_t*)(wl + WL_F);
    const float* w_in = P.in[I_W_IN] + (size_t)l * DM * INW; const float* gmix = P.in[I_NORM_MIX] + (size_t)l * DM; const float* gffn = P.in[I_NORM_FFN] + (size_t)l * DM;
    if (r < CV_J0) { const int kb = r / 64, nb = r % 64; cvt_item(w_in, INW, 64 * kb, 64 * nb, WA, DM, 64 * nb, 0, gmix, 64, scr, lane); return; } r -= CV_J0;
    if (r < CV_J1) { const int kb = r / 24, nb = r % 24; cvt_item(w_in, INW, 64 * kb, 4104 + 64 * nb, WA, DM, 4096 + 64 * nb, 0, gmix, 64, scr, lane); return; } r -= CV_J1;
    if (r < CV_J2) { const int kb = r; cvt_item(w_in, INW, 64 * kb, 4096, WA, DM, 5632, 0, gmix, 8, scr, lane); return; } r -= CV_J2;
    if (r < 4 * CV_JG) { const int g = r / CV_JG, q = r % CV_JG, kb = q / 32, nb = q % 32;
        cvt_item(P.in[I_W_GATE] + ((size_t)l * 4 + g) * DM * DM, DM, 64 * kb, 64 * nb, WA, DM, 5888 + 2048 * g + (nb >> 2) * 256 + 32 * (nb & 3), 0, gmix, 64, scr, lane, true); return; } r -= 4 * CV_JG;
    if (r < 4 * CV_JC) { const int g = r / CV_JC, q = r % CV_JC, kb = q / 32, nb = q % 32;
        cvt_item(P.in[I_W_BRANCH] + ((size_t)l * 4 + g) * BW * DM, DM, 64 * kb, 64 * nb, WC, DM, 64 * nb, 512 * g, nullptr, 64, scr, lane); return; } r -= 4 * CV_JC;
    if (r < CV_JD) { const int kb = r / 32, nb = r % 32; cvt_item(P.in[I_W_OUT] + (size_t)l * DM * DM, DM, 64 * kb, 64 * nb, WD, DM, 64 * nb, 0, nullptr, 64, scr, lane); return; } r -= CV_JD;
    if (r < 2 * CV_JE) { const int half = r / CV_JE, q = r % CV_JE, kb = q / 88, nb = q % 88, c0 = 64 * nb;
        cvt_item(P.in[half ? I_W_FFN_UP : I_W_FFN_GATE] + (size_t)l * DM * FF, FF, 64 * kb, c0, WE, DM, (c0 >> 7) * 256 + (c0 & 127) + 128 * half, 0, gffn, 64, scr, lane); return; } r -= 2 * CV_JE;
    { const int kb = r / 32, nb = r % 32; cvt_item(P.in[I_W_FFN_DOWN] + (size_t)l * FF * DM, DM, 64 * kb, 64 * nb, WF, FF, 64 * nb, 0, nullptr, 64, scr, lane); }
}
#ifndef CV_E_PW
#define CV_E_PW 0
#endif
#ifndef CV_A_PW
#define CV_A_PW 0
#endif
constexpr int CV_TAIL_E = 128 * NWAVES * CV_E_PW, CV_TAIL_A = 32 * NWAVES * CV_A_PW, CV_TAIL_TOTAL = CV_TAIL_E + CV_TAIL_A;
static_assert(CV_TAIL_TOTAL <= CV_PER_LAYER, "tail shares");
__device__ __forceinline__ void cvt_tail(const Ptrs& P, int layer, int first, int nw, int per_wave, int widx, LAS unsigned char* lds, int wave, int lane) {
    LAS float* scr = (LAS float*)(lds + wave * (64 * 65 * 4));
    for (int k = 0; k < per_wave; ++k) cvt_dispatch(P, layer * CV_PER_LAYER + first + widx + nw * k, scr, lane);
}
__device__ __forceinline__ void x_row_init(const float* xrow, bf16_t* xbrow, float* strow, int lane) {
    const GAS f32x4* xr = (const GAS f32x4*)xrow + 2 * lane;
    float ss = 0.f;
#pragma unroll
    for (int j = 0; j < 4; ++j) { const f32x4 a = xr[128 * j], b = xr[128 * j + 1];
        ss += ((a.x * a.x + a.y * a.y) + (a.z * a.z + a.w * a.w)) + ((b.x * b.x + b.y * b.y) + (b.z * b.z + b.w * b.w));
        *(GAS u32x4*)(xbrow + 512 * j + 8 * lane) = pack8(a, b); }
    ss = wave_sum(ss);
    if (lane < 32) strow[lane] = lane == 0 ? ss : 0.f;
}
__device__ __forceinline__ void p0_prologue(const Ptrs& P, LAS unsigned char* lds, int vcu, int G, int wave, int lane) {
    LAS float* scr = (LAS float*)(lds + wave * (64 * 65 * 4));
    const int gw = vcu * NWAVES + wave, NGW = G * NWAVES;
    constexpr int REST = CV_PER_LAYER - CV_TAIL_TOTAL;
    for (int it = gw; it < CV_PER_LAYER + (DEPTH - 1) * REST; it += NGW) {
        if (it < CV_PER_LAYER) cvt_dispatch(P, it, scr, lane);
        else { const int r = it - CV_PER_LAYER, l = 1 + r / REST, q = CV_TAIL_TOTAL + r % REST; cvt_dispatch(P, l * CV_PER_LAYER + q, scr, lane); } }
    { bf16_t* WsB = (bf16_t*)(P.ws + WS_SMALLW); const float* w_s = P.in[I_GM_W_S];
      for (int i = gw * 64 + lane; i < DEPTH * 4 * 16384; i += NGW * 64) { const int t = (i >> 7) & 127, p = i & 127; WsB[i] = p <= t ? f2bf(w_s[i]) : (bf16_t)0; }
      bf16_t* WT = (bf16_t*)(P.ws + WS_SMALLW + 1 * MiB);
      for (int i = gw * 64 + lane; i < DEPTH * 2 * 4 * 16384; i += NGW * 64) { const int c = i & 127, d = (i >> 7) & 127, g = (i >> 14) & 3, which = (i >> 16) & 1, l = i >> 17;
          WT[i] = f2bf((which ? P.in[I_LRU_W_I] : P.in[I_LRU_W_R])[((size_t)(l * 4 + g) * 128 + c) * 128 + d]); } }
    { float* lam8 = (float*)(P.ws + WS_SMALLW + 2 * MiB);
      for (int i = gw * 64 + lane; i < DEPTH * 512; i += NGW * 64) lam8[i] = 8.0f * 1.4426950408889634f * logsigf_(P.in[I_LRU_LAMBDA][i]); }
    bf16_t* xb = (bf16_t*)(P.ws + WS_XB); float* st = (float*)(P.ws + WS_STATS);
    for (int m = gw; m < SEQ; m += NGW) x_row_init(P.in[I_X] + (size_t)m * DM, xb + (size_t)m * DM, st + (size_t)m * 32, lane);
}

#ifndef REP_P
#define REP_P 1
#endif
#ifndef REP_A
#define REP_A 1
#endif
#ifndef REP_M1
#define REP_M1 1
#endif
#ifndef REP_M2
#define REP_M2 1
#endif
#ifndef REP_M3
#define REP_M3 1
#endif
#ifndef REP_C
#define REP_C 1
#endif
#ifndef REP_E
#define REP_E 1
#endif

constexpr int TS = 136;
#define MFMA16(cf, rf, acc) __builtin_amdgcn_mfma_f32_16x16x32_bf16((cf), (rf), (acc), 0, 0, 0)
__device__ __forceinline__ s16x4 tr16(const LAS bf16_t* p) { return __builtin_amdgcn_ds_read_tr16_b64_v4i16((LAS s16x4*)p); }
__device__ __forceinline__ bf16x8 tr_frag(const LAS bf16_t* tile, int rlo, int rhi, int c0, int lane) {
    const int qq = (lane & 15) >> 2, pp = lane & 3;
    const s16x4 lo = tr16(tile + (rlo + qq) * TS + c0 + 4 * pp), hi = tr16(tile + (rhi + qq) * TS + c0 + 4 * pp);
    return __builtin_shufflevector(lo, hi, 0, 1, 2, 3, 4, 5, 6, 7);
}
__device__ __forceinline__ void unpack8(const u32x4 w, float (&x)[8]) { x[0] = bflo(w.x); x[1] = bfhi(w.x); x[2] = bflo(w.y); x[3] = bfhi(w.y); x[4] = bflo(w.z); x[5] = bfhi(w.z); x[6] = bflo(w.w); x[7] = bfhi(w.w); }
__device__ __forceinline__ u32x4 pack8f(const float (&x)[8]) { u32x4 w; w.x = cvt_pk_bf16(x[0], x[1]); w.y = cvt_pk_bf16(x[2], x[3]); w.z = cvt_pk_bf16(x[4], x[5]); w.w = cvt_pk_bf16(x[6], x[7]); return w; }

__device__ __forceinline__ void mix_gmlp(const Args& args, int l, LAS unsigned char* lds, int unit, int tid) {
    const int c = unit >> 2, g = unit & 3, lane = tid & 63, w = __builtin_amdgcn_readfirstlane(tid >> 6), fr = lane & 15, fq = lane >> 4;
    const bf16_t* proj = (const bf16_t*)(args.ws + WS_PROJ); bf16_t* y = (bf16_t*)(args.ws + WS_Y);
    const float* g_v = args.in[I_GM_NORM_V] + l * 512; const float* b_s = args.in[I_GM_B_S] + l * 512;
    const bf16_t* WsB = (const bf16_t*)(args.ws + WS_SMALLW) + (size_t)(l * 4 + g) * 16384;
    LAS bf16_t* vt = (LAS bf16_t*)lds;
    u32x4 rawv[16];
#pragma unroll
    for (int i = 0; i < 16; ++i) rawv[i] = *(const u32x4*)(proj + ((size_t)c * 128 + 16 * w + i) * PROJ_LD + 512 + 8 * lane);
    const f32x4 gv0 = *(const f32x4*)(g_v + 8 * lane), gv1 = *(const f32x4*)(g_v + 8 * lane + 4);
#pragma unroll
    for (int i = 0; i < 16; ++i) { const int p = 16 * w + i;
        float x[8]; unpack8(rawv[i], x); float ss = 0.f;
#pragma unroll
        for (int j = 0; j < 8; ++j) { x[j] = gelu_tanh(x[j]); ss += x[j] * x[j]; }
        ss = wave_sum(ss); const float rstd = rsqrtf(ss * (1.0f / 512.0f) + EPS);
        if ((lane >> 4) == g) {
#pragma unroll
            for (int j = 0; j < 4; ++j) { x[j] *= rstd * gv0[j]; x[4 + j] *= rstd * gv1[j]; }
            *(LAS u32x4*)(vt + p * TS + 8 * (lane & 15)) = pack8f(x); } }
    __syncthreads();
    f32x4 acc[8];
#pragma unroll
    for (int nb = 0; nb < 8; ++nb) acc[nb] = (f32x4){0.f, 0.f, 0.f, 0.f};
    const int rt = 16 * w + fr;
#pragma unroll
    for (int ks = 0; ks < 4; ++ks) if (32 * ks <= 16 * w + 15) {
        const bf16x8 a = *(const bf16x8*)(WsB + rt * 128 + 32 * ks + 8 * fq);
#pragma unroll
        for (int nb = 0; nb < 8; ++nb) { const bf16x8 b = tr_frag(vt, 32 * ks + 8 * fq, 32 * ks + 8 * fq + 4, 16 * nb, lane); acc[nb] = MFMA16(b, a, acc[nb]); } }
    const size_t row = (size_t)c * 128 + rt; const float bias = b_s[g * 128 + rt];
#pragma unroll
    for (int nb = 0; nb < 8; ++nb) { const int col = g * 128 + 16 * nb + 4 * fq; const u32x2 uu = *(const u32x2*)(proj + row * PROJ_LD + col);
        const float u0 = gelu_tanh(bflo(uu.x)), u1 = gelu_tanh(bfhi(uu.x)), u2 = gelu_tanh(bflo(uu.y)), u3 = gelu_tanh(bfhi(uu.y));
        u32x2 o; o.x = cvt_pk_bf16(u0 * (acc[nb][0] + bias), u1 * (acc[nb][1] + bias)); o.y = cvt_pk_bf16(u2 * (acc[nb][2] + bias), u3 * (acc[nb][3] + bias));
        *(u32x2*)(y + row * DM + col) = o; }
    __syncthreads();
}

constexpr int LRU_RAW = 0, LRU_XCB = 35840, LRU_A = 70656, LRU_BX = 103424, LRU_SEGA = 136192, LRU_SEGH = 138240, LRU_CARRY = 140288;
constexpr size_t LRU_HL = 0, LRU_PL = 16 * MiB;
__device__ __forceinline__ void mix_lru0(const Args& args, int l, LAS unsigned char* lds, int unit, int tid) {
    const int c = unit >> 2, g = unit & 3, lane = tid & 63, w = __builtin_amdgcn_readfirstlane(tid >> 6), fr = lane & 15, fq = lane >> 4, t0 = c * 128;
    const bf16_t* proj = (const bf16_t*)(args.ws + WS_PROJ);
    f32x2* AH = (f32x2*)(args.ws + WS_LRU_AH); float* HL = (float*)(args.ws + WS_NAIVE + LRU_HL); float* PL = (float*)(args.ws + WS_NAIVE + LRU_PL);
    const bf16_t* WT = (const bf16_t*)(args.ws + WS_SMALLW + 1 * MiB);
    const bf16_t* WrT = WT + (size_t)((l * 2 + 0) * 4 + g) * 16384; const bf16_t* WiT = WT + (size_t)((l * 2 + 1) * 4 + g) * 16384;
    const float* cw = args.in[I_LRU_CONV_W] + l * 4 * 512; const float* cb = args.in[I_LRU_CONV_B] + l * 512;
    const float* b_r = args.in[I_LRU_B_R] + l * 512; const float* b_i = args.in[I_LRU_B_I] + l * 512; const float* lam8 = (const float*)(args.ws + WS_SMALLW + 2 * MiB) + l * 512;
    LAS bf16_t* raw = (LAS bf16_t*)(lds + LRU_RAW); LAS bf16_t* xcb = (LAS bf16_t*)(lds + LRU_XCB);
    LAS float* Al = (LAS float*)(lds + LRU_A); LAS float* Bl = (LAS float*)(lds + LRU_BX);
    LAS float* segA = (LAS float*)(lds + LRU_SEGA); LAS float* segH = (LAS float*)(lds + LRU_SEGH);
    for (int idx = tid; idx < 131 * 16; idx += NTHREADS) { const int r = idx >> 4, ck = idx & 15, t = t0 - 3 + r;
        u32x4 v = (u32x4){0u, 0u, 0u, 0u}; if (t >= 0) v = *(const u32x4*)(proj + (size_t)t * PROJ_LD + 2 * 512 + g * 128 + 8 * ck);
        *(LAS u32x4*)(raw + r * TS + 8 * ck) = v; }
    __syncthreads();
    for (int idx = tid; idx < 128 * 16; idx += NTHREADS) { const int t = idx >> 4, ck = idx & 15, ch0 = g * 128 + 8 * ck;
        float a8[8]; { const f32x4 c0 = *(const f32x4*)(cb + ch0), c1 = *(const f32x4*)(cb + ch0 + 4);
#pragma unroll
            for (int j = 0; j < 4; ++j) { a8[j] = c0[j]; a8[4 + j] = c1[j]; } }
#pragma unroll
        for (int k = 0; k < 4; ++k) { float x[8]; unpack8(*(const LAS u32x4*)(raw + (t + k) * TS + 8 * ck), x);
            const f32x4 w0 = *(const f32x4*)(cw + k * 512 + ch0), w1 = *(const f32x4*)(cw + k * 512 + ch0 + 4);
#pragma unroll
            for (int j = 0; j < 4; ++j) { a8[j] += w0[j] * x[j]; a8[4 + j] += w1[j] * x[4 + j]; } }
        *(LAS u32x4*)(xcb + t * TS + 8 * ck) = pack8f(a8); }
    __syncthreads();
    const int rt = 16 * w + fr;
#pragma unroll 1
    for (int hd = 0; hd < 2; ++hd) {
        f32x4 aR[4], aI[4];
#pragma unroll
        for (int nb = 0; nb < 4; ++nb) { aR[nb] = (f32x4){0.f, 0.f, 0.f, 0.f}; aI[nb] = (f32x4){0.f, 0.f, 0.f, 0.f}; }
#pragma unroll
        for (int ks = 0; ks < 4; ++ks) { const bf16x8 a = *(const LAS bf16x8*)(xcb + rt * TS + 32 * ks + 8 * fq);
#pragma unroll
            for (int nb = 0; nb < 4; ++nb) { const int d = 64 * hd + 16 * nb + fr;
                const bf16x8 bR = *(const bf16x8*)(WrT + d * 128 + 32 * ks + 8 * fq), bI = *(const bf16x8*)(WiT + d * 128 + 32 * ks + 8 * fq);
                aR[nb] = MFMA16(bR, a, aR[nb]); aI[nb] = MFMA16(bI, a, aI[nb]); } }
#pragma unroll
        for (int nb = 0; nb < 4; ++nb) { const int d0 = 64 * hd + 16 * nb + 4 * fq, ch = g * 128 + d0;
            const f32x4 br = *(const f32x4*)(b_r + ch), bi = *(const f32x4*)(b_i + ch), lm = *(const f32x4*)(lam8 + ch);
            const u32x2 xw = *(const LAS u32x2*)(xcb + rt * TS + d0); const float xc[4] = {bflo(xw.x), bfhi(xw.x), bflo(xw.y), bfhi(xw.y)};
            f32x4 av, bv;
#pragma unroll
            for (int j = 0; j < 4; ++j) { const float r = sigmoidf_(aR[nb][j] + br[j]), ii = sigmoidf_(aI[nb][j] + bi[j]);
                const float a = __builtin_amdgcn_exp2f(r * lm[j]); av[j] = a; bv[j] = __builtin_amdgcn_sqrtf(fmaxf(1.0f - a * a, 0.f)) * (ii * xc[j]); }
            *(LAS f32x4*)(Al + rt * 64 + 16 * nb + 4 * fq) = av; *(LAS f32x4*)(Bl + rt * 64 + 16 * nb + 4 * fq) = bv; }
        __syncthreads();
        float ap = 1.f, h = 0.f;
#pragma unroll
        for (int i = 0; i < 16; ++i) { const float a = Al[(16 * w + i) * 64 + lane], b = Bl[(16 * w + i) * 64 + lane]; h = a * h + b; ap *= a; }
        segA[w * 64 + lane] = ap; segH[w * 64 + lane] = h;
        __syncthreads();
        float hin = 0.f, pin = 1.f;
        for (int s = 0; s < w; ++s) { const float a = segA[s * 64 + lane]; hin = a * hin + segH[s * 64 + lane]; pin *= a; }
        const int chn = g * 128 + 64 * hd + lane;
#pragma unroll
        for (int i = 0; i < 16; ++i) { const int t = 16 * w + i; const float a = Al[t * 64 + lane], b = Bl[t * 64 + lane]; hin = a * hin + b; pin *= a;
            HL[(size_t)(t0 + t) * 512 + chn] = hin; PL[(size_t)(t0 + t) * 512 + chn] = pin; }
        if (w == 7) AH[(size_t)c * 512 + chn] = (f32x2){pin, hin};
        __syncthreads();
    }
}
__device__ __forceinline__ void mix_lru1(const Args& args, int l, LAS unsigned char* lds, int unit, int tid) {
    const int c = unit >> 2, g = unit & 3, t0 = c * 128;
    const bf16_t* proj = (const bf16_t*)(args.ws + WS_PROJ); bf16_t* y = (bf16_t*)(args.ws + WS_Y);
    const f32x2* AH = (const f32x2*)(args.ws + WS_LRU_AH); const float* HL = (const float*)(args.ws + WS_NAIVE + LRU_HL); const float* PL = (const float*)(args.ws + WS_NAIVE + LRU_PL);
    LAS float* carry = (LAS float*)(lds + LRU_CARRY);
    const int cq = tid & 31, r0 = tid >> 5, chn = g * 128 + 4 * cq;
    f32x4 hl[8], pl[8]; u32x2 gt[8];
#pragma unroll
    for (int i = 0; i < 8; ++i) { const size_t row = (size_t)t0 + 16 * i + r0; hl[i] = *(const f32x4*)(HL + row * 512 + chn); pl[i] = *(const f32x4*)(PL + row * 512 + chn); gt[i] = *(const u32x2*)(proj + row * PROJ_LD + 3 * 512 + chn); }
    if (tid < 128) { float hc = 0.f; const f32x2* p = AH + g * 128 + tid;
        for (int c0 = 0; c0 < c; c0 += 8) { f32x2 v[8];
#pragma unroll
            for (int i = 0; i < 8; ++i) v[i] = (c0 + i < c) ? p[(size_t)(c0 + i) * 512] : (f32x2){1.f, 0.f};
#pragma unroll
            for (int i = 0; i < 8; ++i) hc = v[i].x * hc + v[i].y; }
        carry[tid] = hc; }
    __syncthreads();
    const f32x4 cy = *(const LAS f32x4*)(carry + 4 * cq);
#pragma unroll
    for (int i = 0; i < 8; ++i) { const size_t row = (size_t)t0 + 16 * i + r0; const f32x4 hv = hl[i] + pl[i] * cy;
        u32x2 o; o.x = cvt_pk_bf16(hv[0] * gelu_tanh(bflo(gt[i].x)), hv[1] * gelu_tanh(bfhi(gt[i].x))); o.y = cvt_pk_bf16(hv[2] * gelu_tanh(bflo(gt[i].y)), hv[3] * gelu_tanh(bfhi(gt[i].y)));
        *(u32x2*)(y + row * DM + 512 + chn) = o; }
    __syncthreads();
}
constexpr int AT_K = 0, AT_V = 17408, AT_KR = 34816, AT_DONE = 35072;
constexpr float AT_RMIN = -127.0f;
__device__ __forceinline__ void mix_attn(const Args& args, int l, LAS unsigned char* lds, int unit, int tid) {
    const int h = unit & 3, qt = unit >> 2, lane = tid & 63, w = __builtin_amdgcn_readfirstlane(tid >> 6), fr = lane & 15, fq = lane >> 4, q0 = qt * 128;
    const int trow = q0 + 16 * w + fr;
    const bf16_t* proj = (const bf16_t*)(args.ws + WS_PROJ); bf16_t* y = (bf16_t*)(args.ws + WS_Y);
    const float* g_q = args.in[I_SB_NORM_Q] + l * 128; const float* g_k = args.in[I_SB_NORM_K] + l * 128;
    LAS bf16_t* Kt = (LAS bf16_t*)(lds + AT_K); LAS bf16_t* Vt = (LAS bf16_t*)(lds + AT_V); LAS float* kr = (LAS float*)(lds + AT_KR); LAS unsigned* done = (LAS unsigned*)(lds + AT_DONE);
    bf16x8 qf[4];
    { float x[4][8]; float ss = 0.f;
#pragma unroll
      for (int ks = 0; ks < 4; ++ks) { unpack8(*(const u32x4*)(proj + (size_t)trow * PROJ_LD + 8 * 512 + h * 128 + 32 * ks + 8 * fq), x[ks]);
#pragma unroll
          for (int e = 0; e < 8; ++e) ss += x[ks][e] * x[ks][e]; }
      ss += __shfl_xor(ss, 16); ss += __shfl_xor(ss, 32);
      const float rstd = rsqrtf(ss * (1.0f / 128.0f) + EPS) * (0.08838834764831845f * 1.4426950408889634f);
#pragma unroll
      for (int ks = 0; ks < 4; ++ks) { const int d0 = 32 * ks + 8 * fq;
          const f32x4 a0 = *(const f32x4*)(g_q + d0), a1 = *(const f32x4*)(g_q + d0 + 4), b0 = *(const f32x4*)(g_k + d0), b1 = *(const f32x4*)(g_k + d0 + 4);
#pragma unroll
          for (int e = 0; e < 4; ++e) { x[ks][e] *= rstd * a0[e] * b0[e]; x[ks][4 + e] *= rstd * a1[e] * b1[e]; }
          qf[ks] = __builtin_bit_cast(bf16x8, pack8f(x[ks])); } }
    f32x4 o[8];
#pragma unroll
    for (int db = 0; db < 8; ++db) o[db] = (f32x4){0.f, 0.f, 0.f, 0.f};
    float R = 0.f; bool mydone = false;
    u32x4 pk[2], pv[2];
#pragma unroll
    for (int i = 0; i < 2; ++i) { const int idx = tid + NTHREADS * i, r = idx >> 4, ck = idx & 15; const size_t s = (size_t)64 * (2 * qt + 1) + r;
        pk[i] = *(const u32x4*)(proj + s * PROJ_LD + 9 * 512 + h * 128 + 8 * ck); pv[i] = *(const u32x4*)(proj + s * PROJ_LD + 10 * 512 + h * 128 + 8 * ck); }
    for (int kt = 2 * qt + 1; kt >= 0; --kt) {
#pragma unroll
        for (int i = 0; i < 2; ++i) { const int idx = tid + NTHREADS * i, r = idx >> 4, ck = idx & 15;
            *(LAS u32x4*)(Kt + r * TS + 8 * ck) = pk[i]; *(LAS u32x4*)(Vt + r * TS + 8 * ck) = pv[i];
            float x[8]; unpack8(pk[i], x); float ss = 0.f;
#pragma unroll
            for (int e = 0; e < 8; ++e) ss += x[e] * x[e];
            ss += __shfl_xor(ss, 1); ss += __shfl_xor(ss, 2); ss += __shfl_xor(ss, 4); ss += __shfl_xor(ss, 8);
            if (ck == 0) kr[r] = rsqrtf(ss * (1.0f / 128.0f) + EPS); }
        if (kt > 0) {
#pragma unroll
            for (int i = 0; i < 2; ++i) { const int idx = tid + NTHREADS * i, r = idx >> 4, ck = idx & 15; const size_t s = (size_t)64 * (kt - 1) + r;
                pk[i] = *(const u32x4*)(proj + s * PROJ_LD + 9 * 512 + h * 128 + 8 * ck); pv[i] = *(const u32x4*)(proj + s * PROJ_LD + 10 * 512 + h * 128 + 8 * ck); } }
        __syncthreads();
        const bool active = !mydone && (64 * kt < q0 + 16 * w + 15);
        if (active) {
            f32x4 s4[4];
#pragma unroll
            for (int nb = 0; nb < 4; ++nb) s4[nb] = (f32x4){0.f, 0.f, 0.f, 0.f};
#pragma unroll
            for (int ks = 0; ks < 4; ++ks)
#pragma unroll
                for (int nb = 0; nb < 4; ++nb) { const bf16x8 cf = *(const LAS bf16x8*)(Kt + (16 * nb + fr) * TS + 32 * ks + 8 * fq); s4[nb] = MFMA16(cf, qf[ks], s4[nb]); }
            float ln[4][4], zz[4][4], RT[4], sfq[4];
#pragma unroll
            for (int nb = 0; nb < 4; ++nb) { const f32x4 k4 = *(const LAS f32x4*)(kr + 16 * nb + 4 * fq); float gs = 0.f;
#pragma unroll
                for (int j = 0; j < 4; ++j) { const int s = 64 * kt + 16 * nb + 4 * fq + j; const bool valid = s < trow; const float z = s4[nb][j] * k4[j];
                    const float sp = fmaxf(z, 0.f) + __builtin_amdgcn_logf(1.0f + __builtin_amdgcn_exp2f(-fabsf(z)));
                    ln[nb][j] = valid ? -sp : 0.f; zz[nb][j] = valid ? z : -1.0e30f; gs += ln[nb][j]; }
                const float b = __shfl_xor(gs, 16); const float pair = gs + b; const float po = __shfl_xor(pair, 32);
                RT[nb] = pair + po; sfq[nb] = ((fq & 1) ? 0.f : b) + ((fq & 2) ? 0.f : po); }
            float att[4][4]; float above = 0.f;
#pragma unroll
            for (int nb = 3; nb >= 0; --nb) { float rem = R + above + sfq[nb];
#pragma unroll
                for (int j = 3; j >= 0; --j) { att[nb][j] = __builtin_amdgcn_exp2f(zz[nb][j] + ln[nb][j] + rem); rem += ln[nb][j]; }
                above += RT[nb]; }
            R += above;
#pragma unroll
            for (int ksv = 0; ksv < 2; ++ksv) { u32x4 pw; pw.x = cvt_pk_bf16(att[2 * ksv][0], att[2 * ksv][1]); pw.y = cvt_pk_bf16(att[2 * ksv][2], att[2 * ksv][3]);
                pw.z = cvt_pk_bf16(att[2 * ksv + 1][0], att[2 * ksv + 1][1]); pw.w = cvt_pk_bf16(att[2 * ksv + 1][2], att[2 * ksv + 1][3]);
                const bf16x8 rf = __builtin_bit_cast(bf16x8, pw);
#pragma unroll
                for (int db = 0; db < 8; ++db) { const bf16x8 cf = tr_frag(Vt, 32 * ksv + 4 * fq, 32 * ksv + 16 + 4 * fq, 16 * db, lane); o[db] = MFMA16(cf, rf, o[db]); } }
            mydone = __all(R < AT_RMIN);
        }
        if (lane == 0) done[w] = mydone ? 1u : 0u;
        __syncthreads();
        unsigned alld = 1u;
#pragma unroll
        for (int i = 0; i < 8; ++i) alld &= done[i];
        if (alld) break;
    }
#pragma unroll
    for (int db = 0; db < 8; ++db) { u32x2 ov; ov.x = cvt_pk_bf16(o[db][0], o[db][1]); ov.y = cvt_pk_bf16(o[db][2], o[db][3]);
        *(u32x2*)(y + (size_t)trow * DM + 1536 + h * 128 + 16 * db + 4 * fq) = ov; }
    __syncthreads();
}

constexpr size_t ML_DC = 0, ML_CP = 16 * MiB, ML_DN = 24 * MiB, ML_NP = 24 * MiB + 256 * 1024, ML_SC = 24 * MiB + 512 * 1024;
struct ConvRaw { u32x4 v[5]; };
__device__ __forceinline__ void conv_load(ConvRaw& R, const bf16_t* proj, int col0, int t0, int tid) {
#pragma unroll
    for (int i = 0; i < 5; ++i) { const int idx = tid + NTHREADS * i, r = idx >> 4, ck = idx & 15, t = t0 - 3 + r;
        R.v[i] = (u32x4){0u, 0u, 0u, 0u}; if (idx < 131 * 16 && t >= 0) R.v[i] = *(const u32x4*)(proj + (size_t)t * PROJ_LD + col0 + 8 * ck); }
}
__device__ __forceinline__ void conv_tile(const ConvRaw& R, const float* cw, int cwstride, const float* cb, LAS bf16_t* raw, LAS bf16_t* outt, float post, int tid) {
#pragma unroll
    for (int i = 0; i < 5; ++i) { const int idx = tid + NTHREADS * i, r = idx >> 4, ck = idx & 15; if (idx < 131 * 16) *(LAS u32x4*)(raw + r * TS + 8 * ck) = R.v[i]; }
    __syncthreads();
    for (int idx = tid; idx < 128 * 16; idx += NTHREADS) { const int t = idx >> 4, ck = idx & 15;
        float a8[8]; { const f32x4 c0 = *(const f32x4*)(cb + 8 * ck), c1 = *(const f32x4*)(cb + 8 * ck + 4);
#pragma unroll
            for (int j = 0; j < 4; ++j) { a8[j] = c0[j]; a8[4 + j] = c1[j]; } }
#pragma unroll
        for (int k = 0; k < 4; ++k) { float x[8]; unpack8(*(const LAS u32x4*)(raw + (t + k) * TS + 8 * ck), x);
            const f32x4 w0 = *(const f32x4*)(cw + k * cwstride + 8 * ck), w1 = *(const f32x4*)(cw + k * cwstride + 8 * ck + 4);
#pragma unroll
            for (int j = 0; j < 4; ++j) { a8[j] += w0[j] * x[j]; a8[4 + j] += w1[j] * x[4 + j]; } }
#pragma unroll
        for (int j = 0; j < 8; ++j) a8[j] = a8[j] * sigmoidf_(a8[j]) * post;
        *(LAS u32x4*)(outt + t * TS + 8 * ck) = pack8f(a8); }
    __syncthreads();
}
constexpr int ML_RAW = 0, ML_T1 = 35840, ML_T2 = 70656, ML_T3 = 105472, ML_ARR = 140288;
__device__ __forceinline__ void mix_ml1(const Args& args, int l, LAS unsigned char* lds, int unit, int tid) {
    const int c = unit >> 2, h = unit & 3, lane = tid & 63, w = __builtin_amdgcn_readfirstlane(tid >> 6), fr = lane & 15, fq = lane >> 4, t0 = c * 128;
    const bf16_t* proj = (const bf16_t*)(args.ws + WS_PROJ); const float* ifg = (const float*)(args.ws + WS_IFG);
    unsigned char* ml = args.ws + WS_ML; float* dC = (float*)(ml + ML_DC); float* dn = (float*)(ml + ML_DN); float* scal = (float*)(ml + ML_SC);
    LAS bf16_t* raw = (LAS bf16_t*)(lds + ML_RAW); LAS bf16_t* KC = (LAS bf16_t*)(lds + ML_T1); LAS bf16_t* VW = (LAS bf16_t*)(lds + ML_T2); LAS float* wl = (LAS float*)(lds + ML_ARR);
    ConvRaw kraw; conv_load(kraw, proj, 5 * 512 + h * 128, t0, tid);
    u32x4 vraw[4];
#pragma unroll
    for (int i = 0; i < 4; ++i) { const int idx = tid + NTHREADS * i, s = idx >> 4, ck = idx & 15; vraw[i] = *(const u32x4*)(proj + (size_t)(t0 + s) * PROJ_LD + 6 * 512 + h * 128 + 8 * ck); }
    if (w == 0) { const float bf = args.in[I_ML_B_F][l * 4 + h], bi = args.in[I_ML_B_I][l * 4 + h]; const int s0 = t0 + 2 * lane;
        const float f0 = logsigf_(ifg[(size_t)s0 * 8 + 4 + h] + bf), f1 = logsigf_(ifg[(size_t)(s0 + 1) * 8 + 4 + h] + bf);
        const float i0 = ifg[(size_t)s0 * 8 + h] + bi, i1 = ifg[(size_t)(s0 + 1) * 8 + h] + bi;
        float P = f0 + f1;
#pragma unroll
        for (int o = 1; o < 64; o <<= 1) { const float n = __shfl_up(P, o); if (lane >= o) P += n; }
        const float blast = __shfl(P, 63); const float g0 = blast - (P - f1) + i0, g1 = blast - P + i1;
        float m = fmaxf(g0, g1);
#pragma unroll
        for (int o = 1; o < 64; o <<= 1) m = fmaxf(m, __shfl_xor(m, o));
        wl[2 * lane] = __expf(g0 - m); wl[2 * lane + 1] = __expf(g1 - m);
        if (lane == 0) { scal[(c * 4 + h) * 4 + 0] = blast; scal[(c * 4 + h) * 4 + 1] = m; } }
    conv_tile(kraw, args.in[I_ML_CONV_W] + l * 4 * 1024 + 512 + h * 128, 1024, args.in[I_ML_CONV_B] + l * 1024 + 512 + h * 128, raw, KC, 0.08838834764831845f, tid);
#pragma unroll
    for (int i = 0; i < 4; ++i) { const int idx = tid + NTHREADS * i, s = idx >> 4, ck = idx & 15; float x[8]; unpack8(vraw[i], x);
        const float ws_ = wl[s];
#pragma unroll
        for (int j = 0; j < 8; ++j) x[j] *= ws_;
        *(LAS u32x4*)(VW + s * TS + 8 * ck) = pack8f(x); }
    __syncthreads();
    f32x4 acc[8];
#pragma unroll
    for (int nb = 0; nb < 8; ++nb) acc[nb] = (f32x4){0.f, 0.f, 0.f, 0.f};
#pragma unroll
    for (int ks = 0; ks < 4; ++ks) { const bf16x8 rf = tr_frag(VW, 32 * ks + 8 * fq, 32 * ks + 8 * fq + 4, 16 * w, lane);
#pragma unroll
        for (int nb = 0; nb < 8; ++nb) { const bf16x8 cf = tr_frag(KC, 32 * ks + 8 * fq, 32 * ks + 8 * fq + 4, 16 * nb, lane); acc[nb] = MFMA16(cf, rf, acc[nb]); } }
    float* dCu = dC + (size_t)(c * 4 + h) * 16384 + (16 * w + fr) * 128 + 4 * fq;
#pragma unroll
    for (int nb = 0; nb < 8; ++nb) *(f32x4*)(dCu + 16 * nb) = acc[nb];
    if (tid < 128) { float s = 0.f;
        for (int ss = 0; ss < 128; ++ss) s += wl[ss] * bf2f(KC[ss * TS + tid]);
        dn[(size_t)(c * 4 + h) * 128 + tid] = s; }
    __syncthreads();
}
__device__ __forceinline__ void mix_ml2(const Args& args, int b, int tid) {
    const int h = b >> 4, sl = b & 15;
    unsigned char* ml = args.ws + WS_ML; const float* dC = (const float*)(ml + ML_DC); unsigned* Cp = (unsigned*)(ml + ML_CP); const float* dn = (const float*)(ml + ML_DN); float* np = (float*)(ml + ML_NP); float* scal = (float*)(ml + ML_SC);
    const int e = sl * 1024 + tid * 2; const bool nthr = (sl == 0 && tid < 128);
    float m = 0.f, C0 = 0.f, C1 = 0.f, n = 0.f;
    for (int c0 = 0; c0 < 64; c0 += 8) {
        f32x2 d[8]; float bl[8], mlc[8], dnv[8];
#pragma unroll
        for (int i = 0; i < 8; ++i) { const int u = (c0 + i) * 4 + h; d[i] = *(const f32x2*)(dC + (size_t)u * 16384 + e); bl[i] = scal[u * 4 + 0]; mlc[i] = scal[u * 4 + 1]; dnv[i] = nthr ? dn[(size_t)u * 128 + tid] : 0.f; }
#pragma unroll
        for (int i = 0; i < 8; ++i) { const int u = (c0 + i) * 4 + h;
            Cp[((size_t)u * 16384 + e) >> 1] = cvt_pk_bf16(C0, C1);
            if (nthr) np[(size_t)u * 128 + tid] = n;
            if (sl == 0 && tid == 0) scal[u * 4 + 2] = m;
            const float mnew = fmaxf(bl[i] + m, mlc[i]); const float dec = __expf(bl[i] + m - mnew), sc = __expf(mlc[i] - mnew);
            C0 = dec * C0 + sc * d[i].x; C1 = dec * C1 + sc * d[i].y; n = dec * n + sc * dnv[i]; m = mnew; }
    }
}
__device__ __forceinline__ void mix_ml3(const Args& args, int l, LAS unsigned char* lds, int unit, int tid) {
    const int c = unit >> 2, h = unit & 3, lane = tid & 63, w = __builtin_amdgcn_readfirstlane(tid >> 6), fr = lane & 15, fq = lane >> 4, t0 = c * 128;
    const bf16_t* proj = (const bf16_t*)(args.ws + WS_PROJ); const float* ifg = (const float*)(args.ws + WS_IFG); bf16_t* y = (bf16_t*)(args.ws + WS_Y);
    unsigned char* ml = args.ws + WS_ML; const bf16_t* Cp = (const bf16_t*)(ml + ML_CP) + (size_t)(c * 4 + h) * 16384; const float* npv = (const float*)(ml + ML_NP) + (size_t)(c * 4 + h) * 128; const float* scal = (const float*)(ml + ML_SC);
    LAS bf16_t* raw = (LAS bf16_t*)(lds + ML_RAW); LAS bf16_t* QC = (LAS bf16_t*)(lds + ML_T1); LAS bf16_t* KC = (LAS bf16_t*)(lds + ML_T2); LAS bf16_t* VT = (LAS bf16_t*)(lds + ML_T3);
    LAS float* bcl = (LAS float*)(lds + ML_ARR); LAS float* gil = bcl + 128; LAS float* mtl = bcl + 256; LAS float* scl = bcl + 384; LAS float* npl = bcl + 512;
    ConvRaw qraw, kraw; conv_load(qraw, proj, 4 * 512 + h * 128, t0, tid); conv_load(kraw, proj, 5 * 512 + h * 128, t0, tid);
    u32x4 vraw[4];
#pragma unroll
    for (int i = 0; i < 4; ++i) { const int idx = tid + NTHREADS * i, s = idx >> 4, ck = idx & 15; vraw[i] = *(const u32x4*)(proj + (size_t)(t0 + s) * PROJ_LD + 6 * 512 + h * 128 + 8 * ck); }
    if (w == 0) { const float bf = args.in[I_ML_B_F][l * 4 + h], bi = args.in[I_ML_B_I][l * 4 + h]; const int s0 = t0 + 2 * lane; const float mprev = scal[(c * 4 + h) * 4 + 2];
        const float f0 = logsigf_(ifg[(size_t)s0 * 8 + 4 + h] + bf), f1 = logsigf_(ifg[(size_t)(s0 + 1) * 8 + 4 + h] + bf);
        const float i0 = ifg[(size_t)s0 * 8 + h] + bi, i1 = ifg[(size_t)(s0 + 1) * 8 + h] + bi;
        float P = f0 + f1;
#pragma unroll
        for (int o = 1; o < 64; o <<= 1) { const float nn = __shfl_up(P, o); if (lane >= o) P += nn; }
        const float bc0 = P - f1, bc1 = P, gi0 = i0 - bc0, gi1 = i1 - bc1;
        float PM = fmaxf(gi0, gi1);
#pragma unroll
        for (int o = 1; o < 64; o <<= 1) { const float nn = __shfl_up(PM, o); if (lane >= o) PM = fmaxf(PM, nn); }
        float pe = __shfl_up(PM, 1); if (lane == 0) pe = -3.0e38f;
        const float M0 = fmaxf(pe, gi0), M1 = PM;
        const float m0 = fmaxf(bc0 + mprev, bc0 + M0), m1 = fmaxf(bc1 + mprev, bc1 + M1);
        bcl[2 * lane] = bc0; bcl[2 * lane + 1] = bc1; gil[2 * lane] = gi0; gil[2 * lane + 1] = gi1; mtl[2 * lane] = m0; mtl[2 * lane + 1] = m1;
        scl[2 * lane] = __expf(bc0 + mprev - m0); scl[2 * lane + 1] = __expf(bc1 + mprev - m1); }
    if (tid >= 128 && tid < 256) npl[tid - 128] = npv[tid - 128];
    conv_tile(qraw, args.in[I_ML_CONV_W] + l * 4 * 1024 + h * 128, 1024, args.in[I_ML_CONV_B] + l * 1024 + h * 128, raw, QC, 1.0f, tid);
    conv_tile(kraw, args.in[I_ML_CONV_W] + l * 4 * 1024 + 512 + h * 128, 1024, args.in[I_ML_CONV_B] + l * 1024 + 512 + h * 128, raw, KC, 0.08838834764831845f, tid);
#pragma unroll
    for (int i = 0; i < 4; ++i) { const int idx = tid + NTHREADS * i, s = idx >> 4, ck = idx & 15; *(LAS u32x4*)(VT + s * TS + 8 * ck) = vraw[i]; }
    __syncthreads();
    const int tl = 16 * w + fr;
    bf16x8 qf[4];
#pragma unroll
    for (int ks = 0; ks < 4; ++ks) qf[ks] = *(const LAS bf16x8*)(QC + tl * TS + 32 * ks + 8 * fq);
    float pv[8][4]; float rs = 0.f; const float bt = bcl[tl] - mtl[tl];
#pragma unroll
    for (int nb = 0; nb < 8; ++nb) { f32x4 s4 = (f32x4){0.f, 0.f, 0.f, 0.f};
        if (nb <= w) {
#pragma unroll
            for (int ks = 0; ks < 4; ++ks) { const bf16x8 cf = *(const LAS bf16x8*)(KC + (16 * nb + fr) * TS + 32 * ks + 8 * fq); s4 = MFMA16(cf, qf[ks], s4); }
            const f32x4 g4 = *(const LAS f32x4*)(gil + 16 * nb + 4 * fq);
#pragma unroll
            for (int j = 0; j < 4; ++j) { const int s = 16 * nb + 4 * fq + j; const float p = (s <= tl) ? s4[j] * __expf(bt + g4[j]) : 0.f; pv[nb][j] = p; rs += p; }
        } else {
#pragma unroll
            for (int j = 0; j < 4; ++j) pv[nb][j] = 0.f; } }
    rs += __shfl_xor(rs, 16); rs += __shfl_xor(rs, 32);
    f32x4 n1[8], n2[8];
#pragma unroll
    for (int db = 0; db < 8; ++db) { n1[db] = (f32x4){0.f, 0.f, 0.f, 0.f}; n2[db] = (f32x4){0.f, 0.f, 0.f, 0.f}; }
#pragma unroll
    for (int ksv = 0; ksv < 4; ++ksv) if (2 * ksv <= w) { u32x4 pw; pw.x = cvt_pk_bf16(pv[2 * ksv][0], pv[2 * ksv][1]); pw.y = cvt_pk_bf16(pv[2 * ksv][2], pv[2 * ksv][3]);
        pw.z = cvt_pk_bf16(pv[2 * ksv + 1][0], pv[2 * ksv + 1][1]); pw.w = cvt_pk_bf16(pv[2 * ksv + 1][2], pv[2 * ksv + 1][3]);
        const bf16x8 rf = __builtin_bit_cast(bf16x8, pw);
#pragma unroll
        for (int db = 0; db < 8; ++db) { const bf16x8 cf = tr_frag(VT, 32 * ksv + 4 * fq, 32 * ksv + 16 + 4 * fq, 16 * db, lane); n1[db] = MFMA16(cf, rf, n1[db]); } }
#pragma unroll
    for (int ks = 0; ks < 4; ++ks)
#pragma unroll
        for (int db = 0; db < 8; ++db) { const bf16x8 cf = *(const bf16x8*)(Cp + (16 * db + fr) * 128 + 32 * ks + 8 * fq); n2[db] = MFMA16(cf, qf[ks], n2[db]); }
    float d2 = 0.f;
#pragma unroll
    for (int ks = 0; ks < 4; ++ks) { float x[8]; unpack8(__builtin_bit_cast(u32x4, qf[ks]), x); const f32x4 a0 = *(const LAS f32x4*)(npl + 32 * ks + 8 * fq), a1 = *(const LAS f32x4*)(npl + 32 * ks + 8 * fq + 4);
#pragma unroll
        for (int e = 0; e < 4; ++e) d2 += x[e] * a0[e] + x[4 + e] * a1[e]; }
    d2 += __shfl_xor(d2, 16); d2 += __shfl_xor(d2, 32);
    const float sct = scl[tl]; const float den = rs + sct * d2; const float dnm = fmaxf(fabsf(den), __expf(-mtl[tl])); const float inv = 1.0f / dnm;
    float ss = 0.f;
#pragma unroll
    for (int db = 0; db < 8; ++db)
#pragma unroll
        for (int j = 0; j < 4; ++j) { const float hv = (n1[db][j] + sct * n2[db][j]) * inv; n1[db][j] = hv; ss += hv * hv; }
    ss += __shfl_xor(ss, 16); ss += __shfl_xor(ss, 32);
    const float rstd = rsqrtf(ss * (1.0f / 128.0f) + EPS);
    const float* g_h = args.in[I_ML_NORM_H] + l * 512 + h * 128; const size_t row = (size_t)t0 + tl;
#pragma unroll
    for (int db = 0; db < 8; ++db) { const int v = 16 * db + 4 * fq; const f32x4 gh = *(const f32x4*)(g_h + v); const u32x2 ow = *(const u32x2*)(proj + row * PROJ_LD + 7 * 512 + h * 128 + v);
        u32x2 ov; ov.x = cvt_pk_bf16(sigmoidf_(bflo(ow.x)) * n1[db][0] * rstd * gh[0], sigmoidf_(bfhi(ow.x)) * n1[db][1] * rstd * gh[1]);
        ov.y = cvt_pk_bf16(sigmoidf_(bflo(ow.y)) * n1[db][2] * rstd * gh[2], sigmoidf_(bfhi(ow.y)) * n1[db][3] * rstd * gh[3]);
        *(u32x2*)(y + row * DM + 1024 + h * 128 + v) = ov; }
    __syncthreads();
}
#ifndef REP_U1
#define REP_U1 1
#endif
#ifndef REP_U2
#define REP_U2 1
#endif
#ifndef REP_U3
#define REP_U3 1
#endif
#define MIX_PRE() int l = l_; asm volatile("" : "+s"(l)); int tid_m = threadIdx.x; asm volatile("" : "+v"(tid_m))
#define MIXER_PHASE_1 do { MIX_PRE(); \
    for (int r_ = 0; r_ < REP_U1; ++r_) for (int u = bx; u < 256; u += G) mix_ml1(args, l, lds, u, tid_m); \
    for (int r_ = 0; r_ < REP_U2; ++r_) for (int u = bx; u < 256; u += G) mix_lru0(args, l, lds, u, tid_m); \
    for (int r_ = 0; r_ < REP_U3; ++r_) for (int u = bx; u < 256; u += G) mix_gmlp(args, l, lds, u, tid_m); \
  } while (0)
#define MIXER_PHASE_2 do { MIX_PRE(); \
    for (int u = bx; u < 64; u += G) mix_ml2(args, u, tid_m); \
    for (int u = bx; u < 256; u += G) mix_attn(args, l, lds, 255 - u, tid_m); \
    for (int u = bx; u < 256; u += G) mix_lru1(args, l, lds, u, tid_m); \
  } while (0)
#define MIXER_PHASE_3 do { MIX_PRE(); \
    for (int u = bx; u < 256; u += G) mix_ml3(args, l, lds, u, tid_m); \
  } while (0)
#ifndef PH_EN_P
#define PH_EN_P 1
#endif
#ifndef PH_EN_A
#define PH_EN_A 1
#endif
#ifndef PH_EN_C
#define PH_EN_C 1
#endif
#ifndef PH_EN_D
#define PH_EN_D 1
#endif
#ifndef PH_EN_E
#define PH_EN_E 1
#endif
#ifndef PH_EN_F
#define PH_EN_F 1
#endif
constexpr int N_PHASES = 1 + 8 * DEPTH;
__global__ void __launch_bounds__(NTHREADS, 2) mk_fwd(Args args) {
    extern __shared__ __attribute__((aligned(16))) unsigned char lds_raw[];
    LAS unsigned char* lds = (LAS unsigned char*)lds_raw;
    const int tid = threadIdx.x, lane = tid & 63, wave = __builtin_amdgcn_readfirstlane(tid >> 6);
    const int G = gridDim.x; const int bx = blockIdx.x; const int vcu = (G % 8 == 0) ? (bx % 8) * (G / 8) + bx / 8 : bx;
    if (tid < 16) ((LAS unsigned*)(lds + LDS_MISC))[tid] = 0u;
    __syncthreads();
    unsigned* barw = (unsigned*)(args.ws + WS_CTL) + 4096;
    XcdBarrier bar = xcd_barrier_post(barw, (volatile LAS unsigned*)(lds + LDS_MISC));
    const Args& P = args;
    const int lo = args.ph_lo, hi = args.ph_hi;
#define IN(k) (lo <= (k) && (k) < hi)
#define BOTH(k) (IN(k) && IN((k) + 1))
#define SEAM(k) do { if (BOTH(k)) xcd_barrier(bar); } while (0)
    if (PH_EN_P && IN(0)) { for (int rep = 0; rep < REP_P; ++rep) p0_prologue(P, lds, vcu, G, wave, lane); SEAM(0); }
#define WSP(T, off) ((T*)(wsb + (off)))
#define OPAQUE_WS() size_t opq_ = 0; asm volatile("" : "+s"(opq_)); unsigned char* wsb = args.ws + opq_; int l = l_; asm volatile("" : "+s"(l)); unsigned char* wl = wsb + WS_W + (size_t)l * WL_STRIDE
    for (int l_ = 0; l_ < DEPTH; ++l_) {
        const int pb = 1 + 8 * l_;
        if (PH_EN_A && IN(pb + 0)) {
            OPAQUE_WS();
            pg8::Gemm g{WSP(bf16_t, WS_XB), (const bf16_t*)(wl + WL_A), SEQ, NA, DM}; pg8::StaticOrder S; S.init(SEQ, NA, G, bx);
            EpiA E{WSP(float, WS_STATS), WSP(bf16_t, WS_PROJ), WSP(float, WS_IFG), WSP(unsigned char, WS_GATES), args.in[I_B_GATE] + (size_t)l * 4 * DM};
            for (int rep = 0; rep < REP_A; ++rep) pg8::gemm_phase<EpiA, pg8::StaticOrder>(lds, g, S, E);
            if (l + 1 < DEPTH && bx >= 224) { int ln = threadIdx.x & 63; asm volatile("" : "+v"(ln)); cvt_tail(args, l + 1, CV_TAIL_E, 32 * NWAVES, CV_A_PW, (bx - 224) * NWAVES + wave, lds, wave, ln); }
            SEAM(pb + 0);
        }
        if (IN(pb + 1)) { for (int rep = 0; rep < REP_M1; ++rep) { MIXER_PHASE_1; } SEAM(pb + 1); }
        if (IN(pb + 2)) { for (int rep = 0; rep < REP_M2; ++rep) { MIXER_PHASE_2; } SEAM(pb + 2); }
        if (IN(pb + 3)) { for (int rep = 0; rep < REP_M3; ++rep) { MIXER_PHASE_3; } SEAM(pb + 3); }
        if (PH_EN_C && IN(pb + 4)) {
            OPAQUE_WS();
            pg8::Gemm g{WSP(bf16_t, WS_Y), (const bf16_t*)(wl + WL_C), SEQ, DM, DM}; pg8::StaticOrder S; S.init(SEQ, DM, G, bx);
            EpiC E{WSP(unsigned char, WS_GATES), WSP(bf16_t, WS_MERGED)};
            for (int rep = 0; rep < REP_C; ++rep) pg8::gemm_phase<EpiC, pg8::StaticOrder>(lds, g, S, E);
            SEAM(pb + 4);
        }
        if (PH_EN_D && IN(pb + 5)) {
            OPAQUE_WS();
            pg8::Gemm g{WSP(bf16_t, WS_MERGED), (const bf16_t*)(wl + WL_D), SEQ, DM, DM}; pg8::StaticOrder S; S.init(SEQ, DM, G, bx);
#ifdef REP_D
            { EpiD<false> E2{WSP(bf16_t, WS_XB), WSP(float, WS_ML + 28 * MiB), nullptr, WSP(bf16_t, WS_NAIVE + 32 * MiB)}; pg8::gemm_phase<EpiD<false>, pg8::StaticOrder>(lds, g, S, E2); }
#endif
            EpiD<false> E{WSP(bf16_t, WS_XB), WSP(float, WS_STATS) + (size_t)SEQ * 32, nullptr, WSP(bf16_t, WS_XB)};
            pg8::gemm_phase<EpiD<false>, pg8::StaticOrder>(lds, g, S, E);
            SEAM(pb + 5);
        }
        if (PH_EN_E && IN(pb + 6)) {
            OPAQUE_WS();
            pg8::Gemm g{WSP(bf16_t, WS_XB), (const bf16_t*)(wl + WL_E), SEQ, 2 * FF, DM}; pg8::StaticOrder S; S.init(SEQ, 2 * FF, G, bx);
            EpiE E{WSP(float, WS_STATS) + (size_t)SEQ * 32, WSP(bf16_t, WS_H)};
            for (int rep = 0; rep < REP_E; ++rep) pg8::gemm_phase<EpiE, pg8::StaticOrder>(lds, g, S, E);
            if (l + 1 < DEPTH && bx >= 128) { int ln = threadIdx.x & 63; asm volatile("" : "+v"(ln)); cvt_tail(args, l + 1, 0, 128 * NWAVES, CV_E_PW, (bx - 128) * NWAVES + wave, lds, wave, ln); }
            SEAM(pb + 6);
        }
        if (PH_EN_F && IN(pb + 7)) {
            OPAQUE_WS();
            pg8::Gemm g{WSP(bf16_t, WS_H), (const bf16_t*)(wl + WL_F), SEQ, DM, FF}; pg8::StaticOrder S; S.init(SEQ, DM, G, bx);
#ifdef REP_F
            { EpiD<false> E2{WSP(bf16_t, WS_XB), WSP(float, WS_ML + 28 * MiB), nullptr, WSP(bf16_t, WS_NAIVE + 32 * MiB)}; pg8::gemm_phase<EpiD<false>, pg8::StaticOrder>(lds, g, S, E2); }
#endif
            if (l + 1 < DEPTH) { EpiD<false> E{WSP(bf16_t, WS_XB), WSP(float, WS_STATS), nullptr, WSP(bf16_t, WS_XB)}; pg8::gemm_phase<EpiD<false>, pg8::StaticOrder>(lds, g, S, E); }
            else { EpiD<true> E{WSP(bf16_t, WS_XB), nullptr, args.out, nullptr}; pg8::gemm_phase<EpiD<true>, pg8::StaticOrder>(lds, g, S, E); }
            if (l_ + 1 < DEPTH) SEAM(pb + 7);
        }
    }
#undef IN
#undef BOTH
#undef SEAM
}

extern "C" void kernel_launch(void* const* d_in, const int* in_sizes, int n_in, void* d_out, int out_size, void* d_ws, size_t ws_size, hipStream_t stream) {
    static int grid = 0;
    if (grid == 0) {
        if (n_in != N_IN || in_sizes[0] != SEQ * DM || out_size != SEQ * DM || ws_size < WS_END) {
            fprintf(stderr, "kernel_launch: unexpected shapes (n_in %d, in0 %d, out %d, ws %zu < %zu); nothing launched\n", n_in, n_in > 0 ? in_sizes[0] : -1, out_size, ws_size, (size_t)WS_END); grid = -1; return; }
        int dev = 0, cus = 0;
        if (hipGetDevice(&dev) != hipSuccess || hipDeviceGetAttribute(&cus, hipDeviceAttributeMultiprocessorCount, dev) != hipSuccess) { grid = -1; return; }
        if (hipFuncSetAttribute((const void*)mk_fwd, hipFuncAttributeMaxDynamicSharedMemorySize, LDS_BYTES) != hipSuccess) { fprintf(stderr, "kernel_launch: hipFuncSetAttribute failed\n"); grid = -1; return; }
        int per_cu = 0;
        if (hipOccupancyMaxActiveBlocksPerMultiprocessor(&per_cu, (const void*)mk_fwd, NTHREADS, LDS_BYTES) != hipSuccess || per_cu < 1) { fprintf(stderr, "kernel_launch: occupancy query says %d\n", per_cu); }
        (void)hipGetLastError();
        grid = cus;
    }
    if (grid < 0) return;
    (void)hipMemsetAsync((char*)d_ws + WS_CTL, 0, 1 * MiB, stream);
    Args a{};
    for (int i = 0; i < N_IN; ++i) a.in[i] = (const float*)d_in[i];
    a.out = (float*)d_out; a.ws = (unsigned char*)d_ws;
    auto launch = [&](int lo, int hi, int flags = 0) { a.ph_lo = lo; a.ph_hi = hi; a.flags = flags; hipLaunchKernelGGL(mk_fwd, dim3(grid), dim3(NTHREADS), LDS_BYTES, stream, a); };
    unsigned char* ws = (unsigned char*)d_ws;
    const bf16_t* proj = (const bf16_t*)(ws + WS_PROJ); bf16_t* y = (bf16_t*)(ws + WS_Y); const float* ifg = (const float*)(ws + WS_IFG);
    float* XC = (float*)(ws + WS_NAIVE); float* NA_ = (float*)(ws + WS_NAIVE + 16 * MiB); float* NBX = (float*)(ws + WS_NAIVE + 32 * MiB);
    float* QK = (float*)(ws + WS_NAIVE); float* NF = (float*)(ws + WS_NAIVE + 48 * MiB); float* NG_ = (float*)(ws + WS_NAIVE + 49 * MiB);
    launch(0, N_PHASES, 15);
}
```

```cpp
#include <hip/hip_runtime.h>
#include <cstdio>
#include <cstdint>

#define LAS __attribute__((address_space(3)))
#define GAS __attribute__((address_space(1)))
typedef unsigned short bf16_t;
typedef short bf16x8 __attribute__((ext_vector_type(8)));
typedef short s16x4 __attribute__((ext_vector_type(4)));
typedef float f32x4 __attribute__((ext_vector_type(4)));
typedef float f32x2 __attribute__((ext_vector_type(2)));
typedef unsigned u32x4 __attribute__((ext_vector_type(4)));
typedef unsigned u32x2 __attribute__((ext_vector_type(2)));

constexpr int SEQ = 8192, DM = 2048, DEPTH = 4, BW = 512, GD = 128, NG = 4, FF = 5632, INW = 5640;
constexpr int NA = 14080;
constexpr int PROJ_LD = 5632;
constexpr int GATES_LD = 8192;
constexpr float EPS = 1e-6f;
constexpr int NWAVES = 8, NTHREADS = 512;
constexpr int LDS_BYTES = 160 * 1024;
constexpr int LDS_MISC = LDS_BYTES - 64;

enum { I_X = 0, I_NORM_MIX, I_W_IN, I_GM_NORM_V, I_GM_W_S, I_GM_B_S, I_LRU_CONV_W, I_LRU_CONV_B, I_LRU_W_R, I_LRU_B_R, I_LRU_W_I, I_LRU_B_I, I_LRU_LAMBDA,
       I_ML_CONV_W, I_ML_CONV_B, I_ML_B_I, I_ML_B_F, I_ML_NORM_H, I_SB_NORM_Q, I_SB_NORM_K, I_W_BRANCH, I_W_GATE, I_B_GATE, I_W_OUT, I_NORM_FFN,
       I_W_FFN_GATE, I_W_FFN_UP, I_W_FFN_DOWN, N_IN };

constexpr size_t MiB = 1u << 20;
constexpr size_t WS_CTL = 0;
constexpr size_t WS_STATS = 1 * MiB;
constexpr size_t WS_IFG = 3 * MiB;
constexpr size_t WS_LRU_AH = 3 * MiB + 512 * 1024;
constexpr size_t WS_GVS = 3 * MiB + 768 * 1024;
constexpr size_t WS_SMALLW = 4 * MiB;
constexpr size_t WS_XB = 8 * MiB;
constexpr size_t WS_Y = 40 * MiB;
constexpr size_t WS_MERGED = 72 * MiB;
constexpr size_t WS_PROJ = 104 * MiB;
constexpr size_t WS_GATES = 192 * MiB;
constexpr size_t WS_H = WS_PROJ;
constexpr size_t WS_ML = 320 * MiB;
constexpr size_t WS_NAIVE = 352 * MiB;
constexpr size_t WS_W = 416 * MiB;
constexpr size_t WL_A = 0, WL_C = 55 * MiB, WL_D = 63 * MiB, WL_E = 71 * MiB, WL_F = 115 * MiB, WL_STRIDE = 137 * MiB;
constexpr size_t WS_END = WS_W + DEPTH * WL_STRIDE;

typedef __bf16 bf16x2_t __attribute__((ext_vector_type(2)));
__device__ __forceinline__ unsigned cvt_pk_bf16(float lo, float hi) { const f32x2 v = {lo, hi}; return __builtin_bit_cast(unsigned, __builtin_convertvector(v, bf16x2_t)); }
__device__ __forceinline__ bf16_t f2bf(float f) { unsigned u = __builtin_bit_cast(unsigned, f); return (bf16_t)((u + 0x7fffu + ((u >> 16) & 1u)) >> 16); }
__device__ __forceinline__ float bf2f(bf16_t b) { return __builtin_bit_cast(float, (unsigned)b << 16); }
__device__ __forceinline__ float bflo(unsigned w) { return __builtin_bit_cast(float, w << 16); }
__device__ __forceinline__ float bfhi(unsigned w) { return __builtin_bit_cast(float, w & 0xffff0000u); }
__device__ __forceinline__ float sigmoidf_(float x) { return __builtin_amdgcn_rcpf(1.0f + __builtin_amdgcn_exp2f(-1.4426950408889634f * x)); }
__device__ __forceinline__ float gelu_tanh(float x) { const float u = 0.7978845608028654f * (x + 0.044715f * x * x * x); return x * sigmoidf_(2.0f * u); }
__device__ __forceinline__ float softplusf_(float x) { return fmaxf(x, 0.f) + log1pf(__expf(-fabsf(x))); }
__device__ __forceinline__ float logsigf_(float x) { return -softplusf_(-x); }
__device__ __forceinline__ float wave_sum(float v) {
#pragma unroll
    for (int o = 1; o < 64; o <<= 1) v += __shfl_xor(v, o);
    return v;
}
#define LDS_WAIT() asm volatile("s_waitcnt lgkmcnt(0)" ::: "memory")
#define VM_WAIT() asm volatile("s_waitcnt vmcnt(0)" ::: "memory")
namespace pg8 {
#define PG8_LAS __attribute__((address_space(3)))
constexpr int BM = 256, BK = 64, HALF = 128, HTB = HALF * BK * 2  , STAGE_BYTES = 8 * HTB, NXCD = 8, WGM = 8;

__host__ __device__ __forceinline__ int lds_byte(int r, int c) { const int st = (r >> 4) * 2 + (c >> 5), rr = r & 15, cc = c & 31, ob = rr * 64 + cc * 2; return st * 1024 + (ob ^ (((ob >> 9) & 1) << 5)); }
__host__ __device__ __forceinline__ void stage_rc(int b, int& R, int& C) { const int st = b / 1024, sb = b % 1024, swz = sb ^ (((sb >> 9) & 1) << 5); R = (st >> 1) * 16 + swz / 64; C = (st & 1) * 32 + (swz % 64) / 2; }
__host__ __device__ __forceinline__ int perm32(int rho) { const int n = rho >> 4, i = rho & 15; return 8 * (i >> 2) + 4 * n + (i & 3); }

struct Unit { int pm, pn; };
struct Gemm { const bf16_t* A; const bf16_t* Bt; int M, N, K; };

struct StaticOrder {
    int nM, nN, nwg, G, c;
    __host__ __device__ void init(int M, int N, int G_, int c_) { nM = M / BM; nN = N / BM; nwg = nM * nN; G = G_; c = c_; }
    __host__ __device__ bool next(int i, Unit& u) const {
        const long L = (long)i * G + c; if (L >= nwg) return false;
        int wgid = (int)L; { const int q = nwg / NXCD, r = nwg % NXCD, xcd = wgid % NXCD, off = wgid / NXCD; wgid = (xcd < r ? xcd * (q + 1) : r * (q + 1) + (xcd - r) * q) + off; }
        const int nig = WGM * nN, gid = wgid / nig, fm = gid * WGM, gsz = (nM - fm) < WGM ? (nM - fm) : WGM;
        u.pm = fm + ((wgid % nig) % gsz); u.pn = (wgid % nig) / gsz; return true;
    }
};

struct PanelOrder {
    int nM, nN, nwg, G, c;
    __host__ __device__ void init(int M, int N, int G_, int c_) { nM = M / BM; nN = N / BM; nwg = nM * nN; G = G_; c = c_; }
    __host__ __device__ bool next(int i, Unit& u) const {
        if (G != 256 || nM != 32) { const long L = (long)i * G + c; if (L >= nwg) return false; u.pm = (int)(L % nM); u.pn = (int)(L / nM); return true; }
        const int x = c & 7, j = c >> 3, q = i * 32 + j;
        if (q >= 4 * nN) return false;
        u.pm = 4 * x + (q & 3); u.pn = q >> 2; return true;
    }
};
template <class Epi, class Sched>
__device__ __forceinline__ void gemm_phase(PG8_LAS unsigned char* lds, const Gemm g, const Sched& S, const Epi& E) {
    int tid_ = threadIdx.x; asm volatile("" : "+v"(tid_));
    const int tid = tid_, wid = __builtin_amdgcn_readfirstlane(tid >> 6), lane = tid & 63, wr = wid >> 2, wc = wid & 3, fr = lane & 15, fq = lane >> 4;
    const int K = g.K, nt = K / BK;
    unsigned voffA[2], voffB[2];
#pragma unroll
    for (int i = 0; i < 2; ++i) { int R, C; stage_rc(tid * 16 + i * 8192, R, C); const int Rb = Epi::PERM ? ((R & ~31) + perm32(R & 31)) : R;
        voffA[i] = (unsigned)(R * K + C) * 2u; voffB[i] = (unsigned)(Rb * K + C) * 2u; }
    const size_t kstep = (size_t)(BK * 2);
    const size_t hstep = (size_t)HALF * K * 2;
    const size_t tstep = 2 * hstep;
    const unsigned ldsw = (unsigned)wid * 1024u;
    const int aoff = lds_byte(wr * 64 + fr, fq * 8), boff = lds_byte(wc * 32 + fr, fq * 8);
#define PG8_SA(b, h) (((b) * 2 + (h)) * HTB)
#define PG8_SB(b, h) ((4 + (b) * 2 + (h)) * HTB)
#define PG8_STAGE(bufoff, gbase, voff) do { _Pragma("unroll") for (int _i = 0; _i < 2; ++_i) \
        __builtin_amdgcn_global_load_lds((const unsigned*)((const char*)(gbase) + (voff)[_i]), (PG8_LAS unsigned*)(lds + (bufoff) + ldsw + _i * 8192), 16, 0, 0); } while (0)
#define PG8_LDA(dst, b, h) do { _Pragma("unroll") for (int m = 0; m < 4; ++m) _Pragma("unroll") for (int k = 0; k < 2; ++k) dst[m][k] = *(const PG8_LAS bf16x8*)(lds + PG8_SA(b, h) + aoff + m * 2048 + k * 1024); } while (0)
#define PG8_LDB(dst, b, h) do { _Pragma("unroll") for (int n = 0; n < 2; ++n) _Pragma("unroll") for (int k = 0; k < 2; ++k) dst[n][k] = *(const PG8_LAS bf16x8*)(lds + PG8_SB(b, h) + boff + n * 2048 + k * 1024); } while (0)
#define PG8_MMA(ai, bj, At, Bt) do { __builtin_amdgcn_s_setprio(1); _Pragma("unroll") for (int m = 0; m < 4; ++m) _Pragma("unroll") for (int n = 0; n < 2; ++n) _Pragma("unroll") for (int k = 0; k < 2; ++k) \
        acc[ai][bj][m][n] = __builtin_amdgcn_mfma_f32_16x16x32_bf16(Bt[n][k], At[m][k], acc[ai][bj][m][n], 0, 0, 0); __builtin_amdgcn_s_setprio(0); } while (0)
#define PG8_WAIT_V(n) asm volatile("s_waitcnt vmcnt(" #n ")" ::: "memory")
#define PG8_WAIT_L(n) asm volatile("s_waitcnt lgkmcnt(" #n ")" ::: "memory")
#define PG8_BAR __builtin_amdgcn_s_barrier()
#define PG8_SCHED __builtin_amdgcn_sched_barrier(0)
    Unit cur, nxt; int ui = 0;
    if (!S.next(0, cur)) return;
    f32x4 acc[2][2][4][2];
#pragma unroll
    for (int a = 0; a < 2; ++a)
#pragma unroll
        for (int b = 0; b < 2; ++b)
#pragma unroll
            for (int m = 0; m < 4; ++m)
#pragma unroll
                for (int n = 0; n < 2; ++n) acc[a][b][m][n] = (f32x4){0.f, 0.f, 0.f, 0.f};
    bf16x8 At[4][2], B0[2][2], B1[2][2];
    const char* cA = (const char*)g.A + (size_t)cur.pm * tstep; const char* cB = (const char*)g.Bt + (size_t)cur.pn * tstep;
    int cached_pm = -1;
    E.next(cur, 0, lds, wid, lane);
    PG8_STAGE(PG8_SB(0, 0), cB, voffB); PG8_STAGE(PG8_SB(0, 1), cB + hstep, voffB); PG8_STAGE(PG8_SA(0, 0), cA, voffA); PG8_STAGE(PG8_SA(0, 1), cA + hstep, voffA);
    if (wr == 1) PG8_BAR;
    PG8_WAIT_V(2); PG8_BAR;
    PG8_STAGE(PG8_SB(1, 0), cB + kstep, voffB); PG8_STAGE(PG8_SA(1, 0), cA + kstep, voffA); PG8_STAGE(PG8_SB(1, 1), cB + hstep + kstep, voffB);
    PG8_WAIT_V(6); PG8_BAR;
    for (;;) {
        const bool has_next = S.next(ui + 1, nxt);
        const char* nA = has_next ? (const char*)g.A + (size_t)nxt.pm * tstep : cA; const char* nB = has_next ? (const char*)g.Bt + (size_t)nxt.pn * tstep : cB;
        for (int t = 0; t < nt; t += 2) {
            const bool last = (t == nt - 2);
            const char* a1 = cA + (size_t)(t + 1) * kstep;
            const char* a2 = last ? nA : cA + (size_t)(t + 2) * kstep; const char* b2 = last ? nB : cB + (size_t)(t + 2) * kstep;
            const char* a3 = a2 + kstep; const char* b3 = b2 + kstep;
            PG8_LDB(B0, 0, 0); PG8_LDB(B1, 0, 1); PG8_SCHED; PG8_LDA(At, 0, 0); PG8_STAGE(PG8_SA(1, 1), a1 + hstep, voffA);
            PG8_WAIT_V(8); PG8_WAIT_L(0); PG8_BAR; PG8_MMA(0, 0, At, B0); PG8_MMA(0, 1, At, B1); PG8_BAR; PG8_SCHED;
            PG8_LDA(At, 0, 1); PG8_STAGE(PG8_SB(0, 0), b2, voffB); PG8_STAGE(PG8_SB(0, 1), b2 + hstep, voffB); PG8_STAGE(PG8_SA(0, 0), a2, voffA);
            PG8_WAIT_V(8); PG8_WAIT_L(0); PG8_BAR; PG8_MMA(1, 0, At, B0); PG8_MMA(1, 1, At, B1); PG8_BAR; PG8_SCHED;
            PG8_LDB(B0, 1, 0); PG8_LDB(B1, 1, 1); PG8_SCHED; PG8_LDA(At, 1, 0); PG8_STAGE(PG8_SA(0, 1), a2 + hstep, voffA);
            PG8_WAIT_V(8); PG8_WAIT_L(0); PG8_BAR; PG8_MMA(0, 0, At, B0); PG8_MMA(0, 1, At, B1); PG8_BAR; PG8_SCHED;
            PG8_LDA(At, 1, 1); PG8_STAGE(PG8_SB(1, 0), b3, voffB); PG8_STAGE(PG8_SB(1, 1), b3 + hstep, voffB); PG8_STAGE(PG8_SA(1, 0), a3, voffA);
            PG8_WAIT_V(8); PG8_WAIT_L(0); PG8_BAR; PG8_MMA(1, 0, At, B0); PG8_MMA(1, 1, At, B1); PG8_BAR; PG8_SCHED;
            if constexpr (Epi::FOLD) { if (!last && ((t + 2) & 7) == 0) {
                if (wr == 0) PG8_BAR; E.fold(acc, cur, ((t + 2) >> 3) - 1, wr, wc, fr, fq); PG8_SCHED; if (wr == 1) PG8_BAR; } }
        }
        if (wr == 0) PG8_BAR;
        E.prep(cur, cached_pm, lds, wid, lane);
        E(acc, cur, ui, lds, wid, wr, wc, fr, fq);
        if (has_next) E.next(nxt, ui + 1, lds, wid, lane);
#ifdef REP_EPI
        if constexpr (Epi::REPEAT == REP_EPI) { PG8_SCHED; E(acc, cur, ui, lds, wid, wr, wc, fr, fq); }
#endif
        if (!has_next) break;
#pragma unroll
        for (int a = 0; a < 2; ++a)
#pragma unroll
            for (int b = 0; b < 2; ++b)
#pragma unroll
                for (int m = 0; m < 4; ++m)
#pragma unroll
                    for (int n = 0; n < 2; ++n) acc[a][b][m][n] = (f32x4){0.f, 0.f, 0.f, 0.f};
        cur = nxt; cA = nA; cB = nB; ++ui;
        if (wr == 1) PG8_BAR;
    }
    PG8_WAIT_V(0);
    PG8_BAR;
#undef PG8_SA
#undef PG8_SB
#undef PG8_STAGE
#undef PG8_LDA
#undef PG8_LDB
#undef PG8_MMA
#undef PG8_WAIT_V
#undef PG8_WAIT_L
#undef PG8_BAR
#undef PG8_SCHED
}
}
#define XB_TMO      128
#define XB_XCNT(j)  (256  + 64 * (j))
#define XB_XSUB(j)  (1280 + 64 * (j))
#define XB_XGEN(j)  (2304 + 64 * (j))
#define XB_TOP      3328
#define XB_TOPGEN   3392
#define XCD_BAR_WORDS 3456
#define XB_SPIN_CAP (1u << 18)

__device__ __forceinline__ unsigned xb_ld(unsigned* p)              { return __hip_atomic_load(p, __ATOMIC_RELAXED, __HIP_MEMORY_SCOPE_AGENT); }
__device__ __forceinline__ unsigned xb_add(unsigned* p, unsigned v) { return __hip_atomic_fetch_add(p, v, __ATOMIC_RELAXED, __HIP_MEMORY_SCOPE_AGENT); }
__device__ __forceinline__ unsigned xb_xcc_id() { return (unsigned)__builtin_amdgcn_s_getreg((3 << 11) | 20) & 0xFu; }
#define XB_SPIN(cond, bar) do { unsigned _sp = 0; while (cond) { __builtin_amdgcn_s_sleep(1); \
    if ((++_sp & 255u) == 0u) { if (xb_ld(&(bar)[XB_TMO])) break; if (_sp > XB_SPIN_CAP) { atomicAdd(&(bar)[XB_TMO], 1u); break; } } } } while (0)

struct XcdBarrier {
    unsigned* bar; unsigned x;
    volatile LAS unsigned* st;
};

__device__ __forceinline__ XcdBarrier xcd_barrier_post(unsigned* bar, volatile LAS unsigned* st) {
    XcdBarrier b; b.bar = bar; b.x = xb_xcc_id(); b.st = st;
    if (threadIdx.x == 0) (void)xb_add(&bar[XB_XCNT(b.x)], 1u);
    return b;
}
__device__ __forceinline__ void xcd_barrier_complete(unsigned* bar, unsigned x, unsigned& nloc, unsigned& nx) {
    const unsigned G = gridDim.x * gridDim.y * gridDim.z;
    unsigned sum, cnt, mine, sp = 0u;
    for (;;) {
        sum = 0u; cnt = 0u; mine = 0u;
#pragma unroll
        for (unsigned j = 0; j < 16; ++j) { const unsigned c = xb_ld(&bar[XB_XCNT(j)]); sum += c; cnt += (c > 0u) ? 1u : 0u; mine = (j == x) ? c : mine; }
        if (sum == G) break;
        __builtin_amdgcn_s_sleep(1);
        if ((++sp & 255u) == 0u) { if (xb_ld(&bar[XB_TMO])) break; if (sp > XB_SPIN_CAP) { atomicAdd(&bar[XB_TMO], 1u); break; } }
    }
    nloc = mine > 0u ? mine : 1u; nx = cnt > 0u ? cnt : 1u;
}

__device__ __forceinline__ void xcd_barrier(const XcdBarrier& b) {
    asm volatile("s_waitcnt vmcnt(0)" ::: "memory");
    __syncthreads();
    if (threadIdx.x == 0) {
        unsigned* bar = b.bar;
        __builtin_amdgcn_s_waitcnt(0);
        unsigned nloc = b.st[0], nx = b.st[1];
        if (nloc == 0u) { xcd_barrier_complete(bar, b.x, nloc, nx); b.st[0] = nloc; b.st[1] = nx; }
        const unsigned old = xb_add(&bar[XB_XSUB(b.x)], 1u);
        const unsigned gen = old / nloc;
        if (old + 1u == (gen + 1u) * nloc) {
            __builtin_amdgcn_fence(__ATOMIC_RELEASE, "agent");
            asm volatile("s_waitcnt vmcnt(0)" ::: "memory");
            const unsigned og = xb_add(&bar[XB_TOP], 1u);
            const unsigned tg = og / nx;
            if (og + 1u == (tg + 1u) * nx) xb_add(&bar[XB_TOPGEN], 1u);
            else XB_SPIN(xb_ld(&bar[XB_TOPGEN]) == tg, bar);
            __builtin_amdgcn_fence(__ATOMIC_ACQUIRE, "agent");
            xb_add(&bar[XB_XGEN(b.x)], 1u);
            asm volatile("s_waitcnt vmcnt(0)" ::: "memory");
        } else {
            XB_SPIN(xb_ld(&bar[XB_XGEN(b.x)]) == gen, bar);
            __builtin_amdgcn_fence(__ATOMIC_ACQUIRE, "agent");
            asm volatile("s_waitcnt vmcnt(0)" ::: "memory");
        }
    }
    __syncthreads();
}
constexpr int EPI_RSTD = 131072, EPI_BIAS = 131072 + 4096;
__device__ __forceinline__ void rstd_prep(const float* stats, const pg8::Unit& u, int& cached_pm, LAS unsigned char* lds, int wid, int lane) {
    if (u.pm == cached_pm) return;
    cached_pm = u.pm;
    LAS float* tab = (LAS float*)(lds + EPI_RSTD + wid * 512); const int wr = wid >> 2;
#pragma unroll
    for (int q = 0; q < 2; ++q) { const int j = lane + 64 * q, row = u.pm * 256 + (j >> 6) * 128 + wr * 64 + (j & 63);
        const f32x4* p = (const f32x4*)(stats + (size_t)row * 32); f32x4 s = p[0];
#pragma unroll
        for (int i = 1; i < 8; ++i) s = s + p[i];
        tab[j] = rsqrtf(((s.x + s.y) + (s.z + s.w)) * (1.0f / (float)DM) + EPS); }
    LDS_WAIT();
}
__device__ __forceinline__ void load_rstd(LAS unsigned char* lds, int wid, int fr, float (&rs)[2][4]) {
    const LAS float* tab = (const LAS float*)(lds + EPI_RSTD + wid * 512);
#pragma unroll
    for (int ai = 0; ai < 2; ++ai)
#pragma unroll
        for (int m = 0; m < 4; ++m) rs[ai][m] = tab[ai * 64 + m * 16 + fr];
}
__device__ __forceinline__ u32x4 pack8(const f32x4 v0, const f32x4 v1) { u32x4 w; w.x = cvt_pk_bf16(v0[0], v0[1]); w.y = cvt_pk_bf16(v0[2], v0[3]); w.z = cvt_pk_bf16(v1[0], v1[1]); w.w = cvt_pk_bf16(v1[2], v1[3]); return w; }

struct EpiA {
    static constexpr bool PERM = true, FOLD = false; static constexpr int REPEAT = 1;
    const float* stats; bf16_t* proj; float* ifg; unsigned char* gates; const float* bgate; float* gvs;
    __device__ __forceinline__ void prep(const pg8::Unit& u, int& cached_pm, LAS unsigned char* lds, int wid, int lane) const { rstd_prep(stats, u, cached_pm, lds, wid, lane); }
    __device__ __forceinline__ void next(const pg8::Unit& u, int ui, LAS unsigned char* lds, int wid, int lane) const {
        if (u.pn >= 23 && wid < 4) { const int gi = u.pn - 23;
            __builtin_amdgcn_global_load_lds((const unsigned*)(bgate + (gi >> 3) * 2048 + (gi & 7) * 256 + wid * 64 + lane), (LAS unsigned*)(lds + EPI_BIAS + (ui & 1) * 1024 + wid * 256), 4, 0, 0); }
    }
    __device__ __forceinline__ void operator()(const f32x4 (&acc)[2][2][4][2], const pg8::Unit& u, int ui, LAS unsigned char* lds, int wid, int wr, int wc, int fr_, int fq_) const {
        int fr = fr_, fq = fq_; asm volatile("" : "+v"(fr), "+v"(fq));
        float rs[2][4]; load_rstd(lds, wid, fr, rs);
        const int row0 = u.pm * 256 + wr * 64 + fr;
        if (u.pn < 22) {
            const int col0 = u.pn * 256 + wc * 32 + 8 * fq;
#pragma unroll
            for (int ai = 0; ai < 2; ++ai)
#pragma unroll
                for (int m = 0; m < 4; ++m) { bf16_t* rowp = proj + (size_t)(row0 + ai * 128 + m * 16) * PROJ_LD + col0; const float r = rs[ai][m];
#pragma unroll
                    for (int bj = 0; bj < 2; ++bj) *(u32x4*)(rowp + bj * 128) = pack8(acc[ai][bj][m][0] * r, acc[ai][bj][m][1] * r);
                    if (u.pn == 2 || u.pn == 3) {
                        float ss = 0.f;
#pragma unroll
                        for (int bj = 0; bj < 2; ++bj)
#pragma unroll
                            for (int n = 0; n < 2; ++n)
#pragma unroll
                                for (int j = 0; j < 4; ++j) { const float gv = gelu_tanh(acc[ai][bj][m][n][j] * r); ss += gv * gv; }
                        ss += __shfl_xor(ss, 16); ss += __shfl_xor(ss, 32);
                        if (fq == 0) gvs[(size_t)(row0 + ai * 128 + m * 16) * 8 + (u.pn - 2) * 4 + wc] = ss; } }
        } else if (u.pn == 22) {
            if (wc == 0 && fq == 0) {
#pragma unroll
                for (int ai = 0; ai < 2; ++ai)
#pragma unroll
                    for (int m = 0; m < 4; ++m) { float* p = ifg + (size_t)(row0 + ai * 128 + m * 16) * 8; const float r = rs[ai][m];
                        *(f32x4*)p = acc[ai][0][m][0] * r; *(f32x4*)(p + 4) = acc[ai][0][m][1] * r; }
            }
        } else {
            const int gi = u.pn - 23;
            const LAS float* bl = (const LAS float*)(lds + EPI_BIAS + (ui & 1) * 1024) + wc * 32 + 8 * fq;
            f32x4 bv[2][2];
#pragma unroll
            for (int bj = 0; bj < 2; ++bj)
#pragma unroll
                for (int n = 0; n < 2; ++n) bv[bj][n] = *(const LAS f32x4*)(bl + 128 * bj + 4 * n) * -1.4426950408889634f;
            unsigned char* gp = gates + ((size_t)((u.pm * 8 + (gi & 7)) * 4 + (gi >> 3)) << 16) + wid * 8192 + (fq * 16 + fr) * 16;
#pragma unroll
            for (int ai = 0; ai < 2; ++ai)
#pragma unroll
                for (int m = 0; m < 4; ++m) { const float r = rs[ai][m] * -1.4426950408889634f; u32x4 qw;
#pragma unroll
                    for (int bj = 0; bj < 2; ++bj)
#pragma unroll
                        for (int n = 0; n < 2; ++n) { const f32x4 t = acc[ai][bj][m][n] * r + bv[bj][n]; unsigned w = 0u;
#define SG256(x) (__builtin_amdgcn_rcpf(1.0f + __builtin_amdgcn_exp2f(x)) * 256.0f - 0.5f)
                            w = __builtin_amdgcn_cvt_pk_u8_f32(SG256(t[0]), 0, w); w = __builtin_amdgcn_cvt_pk_u8_f32(SG256(t[1]), 1, w);
                            w = __builtin_amdgcn_cvt_pk_u8_f32(SG256(t[2]), 2, w); w = __builtin_amdgcn_cvt_pk_u8_f32(SG256(t[3]), 3, w);
#undef SG256
                            qw[2 * bj + n] = w; }
                    *(u32x4*)(gp + (ai * 4 + m) * 1024) = qw; }
        }
    }
};
struct EpiC {
    static constexpr bool PERM = true, FOLD = true; static constexpr int REPEAT = 0;
    const unsigned char* gates; bf16_t* merged;
    __device__ __forceinline__ void prep(const pg8::Unit&, int&, LAS unsigned char*, int, int) const {}
    __device__ __forceinline__ void next(const pg8::Unit&, int, LAS unsigned char*, int, int) const {}
    static __device__ __forceinline__ void unq(const u32x2 w, float (&x)[8]) {
        x[0] = (float)(w.x & 0xffu) + 0.5f; x[1] = (float)((w.x >> 8) & 0xffu) + 0.5f; x[2] = (float)((w.x >> 16) & 0xffu) + 0.5f; x[3] = (float)(w.x >> 24) + 0.5f;
        x[4] = (float)(w.y & 0xffu) + 0.5f; x[5] = (float)((w.y >> 8) & 0xffu) + 0.5f; x[6] = (float)((w.y >> 16) & 0xffu) + 0.5f; x[7] = (float)(w.y >> 24) + 0.5f; }
    __device__ __forceinline__ void fold(f32x4 (&acc)[2][2][4][2], const pg8::Unit& u, int g, int wr, int wc, int fr_, int fq_) const {
        int fr = fr_, fq = fq_; asm volatile("" : "+v"(fr), "+v"(fq));
        const unsigned off0 = ((unsigned)((u.pm * 8 + u.pn) * 4 + g) << 16) + (unsigned)((wr * 4 + wc) * 8192 + (fq * 16 + fr) * 16);
        const unsigned char* gb = gates;
#pragma unroll
        for (int ai = 0; ai < 2; ++ai) {
#pragma unroll
            for (int m = 0; m < 4; ++m) { const unsigned off = off0 + (unsigned)((ai * 4 + m) * 1024);
                const u32x4 wa = *(const u32x4*)(gb + off), wb = *(const u32x4*)(gb + off + 65536u);
#pragma unroll
                for (int bj = 0; bj < 2; ++bj) { float a[8], b[8]; unq((u32x2){wa[2 * bj], wa[2 * bj + 1]}, a); unq((u32x2){wb[2 * bj], wb[2 * bj + 1]}, b);
#pragma unroll
                    for (int q = 0; q < 8; q += 2) { const float rp = __builtin_amdgcn_rcpf(b[q] * b[q + 1]);
                        acc[ai][bj][m][q >> 2][q & 3] *= (a[q] * b[q + 1]) * rp; acc[ai][bj][m][q >> 2][(q & 3) + 1] *= (a[q + 1] * b[q]) * rp; } } } }
    }
    __device__ __forceinline__ void operator()(const f32x4 (&acc)[2][2][4][2], const pg8::Unit& u, int, LAS unsigned char*, int wid, int wr, int wc, int fr_, int fq_) const {
        int fr = fr_, fq = fq_; asm volatile("" : "+v"(fr), "+v"(fq));
        const int row0 = u.pm * 256 + wr * 64 + fr, col0 = u.pn * 256 + wc * 32 + 8 * fq;
        const unsigned goff0 = ((unsigned)((u.pm * 8 + u.pn) * 4 + 3) << 16) + (unsigned)(wid * 8192 + (fq * 16 + fr) * 16), moff0 = (unsigned)row0 * (DM * 2u) + (unsigned)col0 * 2u;
        const unsigned char* gb = gates; char* mb = (char*)merged;
#pragma unroll
        for (int ai = 0; ai < 2; ++ai)
#pragma unroll
            for (int m = 0; m < 4; ++m) { const unsigned moff = moff0 + (unsigned)(ai * 128 + m * 16) * (DM * 2u);
                const u32x4 wa = *(const u32x4*)(gb + goff0 + (unsigned)((ai * 4 + m) * 1024));
#pragma unroll
                for (int bj = 0; bj < 2; ++bj) { float a[8]; unq((u32x2){wa[2 * bj], wa[2 * bj + 1]}, a); f32x4 v0 = acc[ai][bj][m][0], v1 = acc[ai][bj][m][1];
#pragma unroll
                    for (int q = 0; q < 4; ++q) { v0[q] *= a[q] * (1.0f / 256.0f); v1[q] *= a[4 + q] * (1.0f / 256.0f); }
                    *(u32x4*)(mb + moff + bj * 256) = pack8(v0, v1); } }
    }
};
template <bool LAST> struct EpiD {
    static constexpr bool PERM = true, FOLD = false; static constexpr int REPEAT = 0;
    bf16_t* xb; float* stats_out; float* out; bf16_t* xdst;
    __device__ __forceinline__ void prep(const pg8::Unit&, int&, LAS unsigned char*, int, int) const {}
    __device__ __forceinline__ void next(const pg8::Unit&, int, LAS unsigned char*, int, int) const {}
    __device__ __forceinline__ void operator()(const f32x4 (&acc)[2][2][4][2], const pg8::Unit& u, int, LAS unsigned char*, int, int wr, int wc, int fr_, int fq) const {
        int fr = fr_; asm volatile("" : "+v"(fr));
        const int row0 = u.pm * 256 + wr * 64 + fr, col0 = u.pn * 256 + wc * 32 + 8 * fq;
#pragma unroll
        for (int ai = 0; ai < 2; ++ai) {
            u32x4 xo[4][2];
#pragma unroll
            for (int m = 0; m < 4; ++m)
#pragma unroll
                for (int bj = 0; bj < 2; ++bj) xo[m][bj] = *(const u32x4*)(xb + (size_t)(row0 + ai * 128 + m * 16) * DM + col0 + bj * 128);
#pragma unroll
            for (int m = 0; m < 4; ++m) { const int row = row0 + ai * 128 + m * 16; const size_t off = (size_t)row * DM + col0; float ss = 0.f;
#pragma unroll
                for (int bj = 0; bj < 2; ++bj) { const u32x4 xw = xo[m][bj];
                    f32x4 v0 = acc[ai][bj][m][0], v1 = acc[ai][bj][m][1];
                    v0[0] += bflo(xw.x); v0[1] += bfhi(xw.x); v0[2] += bflo(xw.y); v0[3] += bfhi(xw.y); v1[0] += bflo(xw.z); v1[1] += bfhi(xw.z); v1[2] += bflo(xw.w); v1[3] += bfhi(xw.w);
                    if (LAST) { *(f32x4*)(out + off + bj * 128) = v0; *(f32x4*)(out + off + bj * 128 + 4) = v1; }
                    else { const u32x4 pw = pack8(v0, v1); *(u32x4*)(xdst + off + bj * 128) = pw;
                        const float r0 = bflo(pw.x), r1 = bfhi(pw.x), r2 = bflo(pw.y), r3 = bfhi(pw.y), r4 = bflo(pw.z), r5 = bfhi(pw.z), r6 = bflo(pw.w), r7 = bfhi(pw.w);
                        ss += ((r0 * r0 + r1 * r1) + (r2 * r2 + r3 * r3)) + ((r4 * r4 + r5 * r5) + (r6 * r6 + r7 * r7)); } }
                if (!LAST) { ss += __shfl_xor(ss, 16); ss += __shfl_xor(ss, 32);
                    if (fq == 0) stats_out[(size_t)row * 32 + u.pn * 4 + wc] = ss; } }
            asm volatile("" ::: "memory"); }
    }
};
struct EpiE {
    static constexpr bool PERM = true, FOLD = false; static constexpr int REPEAT = 2;
    const float* stats; bf16_t* h;
    __device__ __forceinline__ void prep(const pg8::Unit& u, int& cached_pm, LAS unsigned char* lds, int wid, int lane) const { rstd_prep(stats, u, cached_pm, lds, wid, lane); }
    __device__ __forceinline__ void next(const pg8::Unit&, int, LAS unsigned char*, int, int) const {}
    __device__ __forceinline__ void operator()(const f32x4 (&acc)[2][2][4][2], const pg8::Unit& u, int, LAS unsigned char* lds, int wid, int wr, int wc, int fr_, int fq_) const {
        int fr = fr_, fq = fq_; asm volatile("" : "+v"(fr), "+v"(fq));
        float rs[2][4]; load_rstd(lds, wid, fr, rs);
        const int row0 = u.pm * 256 + wr * 64 + fr, col0 = u.pn * 128 + wc * 32 + 8 * fq;
#pragma unroll
        for (int ai = 0; ai < 2; ++ai)
#pragma unroll
            for (int m = 0; m < 4; ++m) { const float r = rs[ai][m]; f32x4 o[2];
#pragma unroll
                for (int n = 0; n < 2; ++n) { const f32x4 gv = acc[ai][0][m][n] * r, uv = acc[ai][1][m][n] * r;
#pragma unroll
                    for (int j = 0; j < 4; ++j) o[n][j] = gv[j] * sigmoidf_(gv[j]) * uv[j]; }
                *(u32x4*)(h + (size_t)(row0 + ai * 128 + m * 16) * FF + col0) = pack8(o[0], o[1]); }
    }
};
__device__ __forceinline__ void cvt_item(const float* W, int ldw, int k0, int c0, bf16_t* WT, size_t dld, int drow0, int dcol0, const float* gain, int nvalid, LAS float* scr, int lane, bool gateperm = false) {
    const int c4 = lane & 15, r4 = lane >> 4;
    f32x4 v[16];
#pragma unroll
    for (int i = 0; i < 16; ++i) v[i] = __builtin_nontemporal_load((const GAS f32x4*)(W + (size_t)(k0 + 4 * i + r4) * ldw + c0 + 4 * c4));
    if (gain) {
#pragma unroll
        for (int i = 0; i < 16; ++i) v[i] = v[i] * gain[k0 + 4 * i + r4];
    }
#pragma unroll
    for (int i = 0; i < 16; ++i)
#pragma unroll
        for (int j = 0; j < 4; ++j) scr[(4 * c4 + j) * 65 + 4 * i + r4] = v[i][j];
    LDS_WAIT();
    const int c = lane & 7, ns = lane >> 3;
#pragma unroll
    for (int p = 0; p < 8; ++p) { const int n = 8 * p + ns; const LAS float* s = scr + n * 65 + 8 * c;
        u32x4 o; o.x = cvt_pk_bf16(s[0], s[1]); o.y = cvt_pk_bf16(s[2], s[3]); o.z = cvt_pk_bf16(s[4], s[5]); o.w = cvt_pk_bf16(s[6], s[7]);
        if (n >= nvalid) o = (u32x4){0u, 0u, 0u, 0u};
        const int nr = gateperm ? 128 * ((n >> 3) & 1) + 8 * (n >> 4) + (n & 7) : n;
        *(GAS u32x4*)(WT + (size_t)(drow0 + nr) * dld + dcol0 + k0 + 8 * c) = o; }
    LDS_WAIT();
}
constexpr int CV_J0 = 2048, CV_J1 = 768, CV_J2 = 32, CV_JG = 1024, CV_JC = 256, CV_JD = 1024, CV_JE = 2816, CV_JF = 2816;
constexpr int CV_PER_LAYER = CV_J0 + CV_J1 + CV_J2 + 4 * CV_JG + 4 * CV_JC + CV_JD + 2 * CV_JE + CV_JF;
struct Args { const float* in[N_IN]; float* out; unsigned char* ws; int ph_lo, ph_hi, flags, pad; };
typedef Args Ptrs;
__device__ __forceinline__ void cvt_dispatch(const Ptrs& P, int it, LAS float* scr, int lane) {
    const int l = it / CV_PER_LAYER; int r = it % CV_PER_LAYER;
    unsigned char* wl = P.ws + WS_W + (size_t)l * WL_STRIDE;
    bf16_t* WA = (bf16_t*)(wl + WL_A); bf16_t* WC = (bf16_t*)(wl + WL_C); bf16_t* WD = (bf16_t*)(wl + WL_D); bf16_t* WE = (bf16_t*)(wl + WL_E); bf16_t* WF = (bf16_t*)(wl + WL_F);
    const float* w_in = P.in[I_W_IN] + (size_t)l * DM * INW; const float* gmix = P.in[I_NORM_MIX] + (size_t)l * DM; const float* gffn = P.in[I_NORM_FFN] + (size_t)l * DM;
    if (r < CV_J0) { const int kb = r / 64, nb = r % 64; cvt_item(w_in, INW, 64 * kb, 64 * nb, WA, DM, 64 * nb, 0, gmix, 64, scr, lane); return; } r -= CV_J0;
    if (r < CV_J1) { const int kb = r / 24, nb = r % 24; cvt_item(w_in, INW, 64 * kb, 4104 + 64 * nb, WA, DM, 4096 + 64 * nb, 0, gmix, 64, scr, lane); return; } r -= CV_J1;
    if (r < CV_J2) { const int kb = r; cvt_item(w_in, INW, 64 * kb, 4096, WA, DM, 5632, 0, gmix, 8, scr, lane); return; } r -= CV_J2;
    if (r < 4 * CV_JG) { const int g = r / CV_JG, q = r % CV_JG, kb = q / 32, nb = q % 32;
        cvt_item(P.in[I_W_GATE] + ((size_t)l * 4 + g) * DM * DM, DM, 64 * kb, 64 * nb, WA, DM, 5888 + 2048 * g + 64 * nb, 0, gmix, 64, scr, lane, false); return; } r -= 4 * CV_JG;
    if (r < 4 * CV_JC) { const int g = r / CV_JC, q = r % CV_JC, kb = q / 32, nb = q % 32;
        cvt_item(P.in[I_W_BRANCH] + ((size_t)l * 4 + g) * BW * DM, DM, 64 * kb, 64 * nb, WC, DM, 64 * nb, 512 * g, nullptr, 64, scr, lane); return; } r -= 4 * CV_JC;
    if (r < CV_JD) { const int kb = r / 32, nb = r % 32; cvt_item(P.in[I_W_OUT] + (size_t)l * DM * DM, DM, 64 * kb, 64 * nb, WD, DM, 64 * nb, 0, nullptr, 64, scr, lane); return; } r -= CV_JD;
    if (r < 2 * CV_JE) { const int half = r / CV_JE, q = r % CV_JE, kb = q / 88, nb = q % 88, c0 = 64 * nb;
        cvt_item(P.in[half ? I_W_FFN_UP : I_W_FFN_GATE] + (size_t)l * DM * FF, FF, 64 * kb, c0, WE, DM, (c0 >> 7) * 256 + (c0 & 127) + 128 * half, 0, gffn, 64, scr, lane); return; } r -= 2 * CV_JE;
    { const int kb = r / 32, nb = r % 32; cvt_item(P.in[I_W_FFN_DOWN] + (size_t)l * FF * DM, DM, 64 * kb, 64 * nb, WF, FF, 64 * nb, 0, nullptr, 64, scr, lane); }
}
#ifndef PRO_STATIC
#define PRO_STATIC 64
#endif
#ifndef CV_E_PW
#define CV_E_PW 0
#endif
#ifndef CV_A_PW
#define CV_A_PW 0
#endif
constexpr int CV_TAIL_E = 128 * NWAVES * CV_E_PW, CV_TAIL_A = 32 * NWAVES * CV_A_PW, CV_TAIL_TOTAL = CV_TAIL_E + CV_TAIL_A;
static_assert(CV_TAIL_TOTAL <= CV_PER_LAYER, "tail shares");
__device__ __forceinline__ void cvt_tail(const Ptrs& P, int layer, int first, int nw, int per_wave, int widx, LAS unsigned char* lds, int wave, int lane) {
    LAS float* scr = (LAS float*)(lds + wave * (64 * 65 * 4));
    for (int k = 0; k < per_wave; ++k) cvt_dispatch(P, layer * CV_PER_LAYER + first + widx + nw * k, scr, lane);
}
__device__ __forceinline__ void x_row_init(const float* xrow, bf16_t* xbrow, float* strow, int lane) {
    const GAS f32x4* xr = (const GAS f32x4*)xrow + 2 * lane;
    float ss = 0.f;
#pragma unroll
    for (int j = 0; j < 4; ++j) { const f32x4 a = xr[128 * j], b = xr[128 * j + 1];
        ss += ((a.x * a.x + a.y * a.y) + (a.z * a.z + a.w * a.w)) + ((b.x * b.x + b.y * b.y) + (b.z * b.z + b.w * b.w));
        *(GAS u32x4*)(xbrow + 512 * j + 8 * lane) = pack8(a, b); }
    ss = wave_sum(ss);
    if (lane < 32) strow[lane] = lane == 0 ? ss : 0.f;
}
__device__ __forceinline__ void p0_prologue(const Ptrs& P, LAS unsigned char* lds, int vcu, int G, int wave, int lane) {
    LAS float* scr = (LAS float*)(lds + wave * (64 * 65 * 4));
    const int gw = vcu * NWAVES + wave, NGW = G * NWAVES;
    constexpr int REST = CV_PER_LAYER - CV_TAIL_TOTAL;
    constexpr int TOTAL = CV_PER_LAYER + (DEPTH - 1) * REST;
    const int nstat = (NGW * PRO_STATIC < TOTAL) ? NGW * PRO_STATIC : TOTAL;
    for (int it = gw; it < nstat; it += NGW) {
        if (it < CV_PER_LAYER) cvt_dispatch(P, it, scr, lane);
        else { const int r = it - CV_PER_LAYER, l = 1 + r / REST, q = CV_TAIL_TOTAL + r % REST; cvt_dispatch(P, l * CV_PER_LAYER + q, scr, lane); } }
    { unsigned* qctr = (unsigned*)(P.ws + WS_CTL + 32 * 1024);
      const int ntail = TOTAL - nstat, per = (ntail + 7) / 8, g0 = (int)(blockIdx.x & 7);
      for (int gg = 0; gg < 8 && ntail > 0; ++gg) { const int grp = (g0 + gg) & 7; const int lo = nstat + grp * per; int cnt = ntail - grp * per; cnt = cnt < 0 ? 0 : (cnt > per ? per : cnt);
          for (;;) { unsigned k = 0; if (lane == 0) k = __hip_atomic_fetch_add(qctr + 64 * grp, 1u, __ATOMIC_RELAXED, __HIP_MEMORY_SCOPE_AGENT);
              k = (unsigned)__builtin_amdgcn_readfirstlane((int)k); if ((int)k >= cnt) break;
              const int it = lo + (int)k;
              if (it < CV_PER_LAYER) cvt_dispatch(P, it, scr, lane);
              else { const int r = it - CV_PER_LAYER, l = 1 + r / REST, q = CV_TAIL_TOTAL + r % REST; cvt_dispatch(P, l * CV_PER_LAYER + q, scr, lane); } } } }
    { bf16_t* WsB = (bf16_t*)(P.ws + WS_SMALLW); const float* w_s = P.in[I_GM_W_S];
      for (int i = gw * 64 + lane; i < DEPTH * 4 * 16384; i += NGW * 64) { const int t = (i >> 7) & 127, p = i & 127; WsB[i] = p <= t ? f2bf(w_s[i]) : (bf16_t)0; }
      bf16_t* WT = (bf16_t*)(P.ws + WS_SMALLW + 1 * MiB);
      for (int i = gw * 64 + lane; i < DEPTH * 2 * 4 * 16384; i += NGW * 64) { const int c = i & 127, d = (i >> 7) & 127, g = (i >> 14) & 3, which = (i >> 16) & 1, l = i >> 17;
          WT[i] = f2bf((which ? P.in[I_LRU_W_I] : P.in[I_LRU_W_R])[((size_t)(l * 4 + g) * 128 + c) * 128 + d]); } }
    { float* lam8 = (float*)(P.ws + WS_SMALLW + 2 * MiB);
      for (int i = gw * 64 + lane; i < DEPTH * 512; i += NGW * 64) lam8[i] = 8.0f * 1.4426950408889634f * logsigf_(P.in[I_LRU_LAMBDA][i]); }
    bf16_t* xb = (bf16_t*)(P.ws + WS_XB); float* st = (float*)(P.ws + WS_STATS);
    for (int m = gw; m < SEQ; m += NGW) x_row_init(P.in[I_X] + (size_t)m * DM, xb + (size_t)m * DM, st + (size_t)m * 32, lane);
}

#ifdef TPROBE
#ifndef TP_OFF
#define TP_OFF 0
#endif
#define TP_BEGIN(k) do { if ((k) == TPROBE) tp_t0 = __builtin_amdgcn_s_memrealtime(); } while (0)
#define TP_END(k) do { if ((k) == TPROBE) tp_sum += (unsigned)(__builtin_amdgcn_s_memrealtime() - tp_t0); } while (0)
#else
#define TP_BEGIN(k) do {} while (0)
#define TP_END(k) do {} while (0)
#endif
#ifndef E_HALF_TAIL
#define E_HALF_TAIL 0
#endif
#if E_HALF_TAIL
#define E_ORDER pg8::HalfTailOrder
#else
#define E_ORDER GEMM_ORDER
#endif
#ifndef GEMM_ORDER
#define GEMM_ORDER pg8::PanelOrder
#endif
#ifndef REP_P
#define REP_P 1
#endif
#ifndef REP_A
#define REP_A 1
#endif
#ifndef REP_M1
#define REP_M1 1
#endif
#ifndef REP_M2
#define REP_M2 1
#endif
#ifndef REP_M3
#define REP_M3 1
#endif
#ifndef REP_C
#define REP_C 1
#endif
#ifndef REP_E
#define REP_E 1
#endif

constexpr int TS = 136;
#define MFMA16(cf, rf, acc) __builtin_amdgcn_mfma_f32_16x16x32_bf16((cf), (rf), (acc), 0, 0, 0)
__device__ __forceinline__ s16x4 tr16(const LAS bf16_t* p) { return __builtin_amdgcn_ds_read_tr16_b64_v4i16((LAS s16x4*)p); }
__device__ __forceinline__ bf16x8 tr_frag(const LAS bf16_t* tile, int rlo, int rhi, int c0, int lane) {
    const int qq = (lane & 15) >> 2, pp = lane & 3;
    const s16x4 lo = tr16(tile + (rlo + qq) * TS + c0 + 4 * pp), hi = tr16(tile + (rhi + qq) * TS + c0 + 4 * pp);
    return __builtin_shufflevector(lo, hi, 0, 1, 2, 3, 4, 5, 6, 7);
}
__device__ __forceinline__ void unpack8(const u32x4 w, float (&x)[8]) { x[0] = bflo(w.x); x[1] = bfhi(w.x); x[2] = bflo(w.y); x[3] = bfhi(w.y); x[4] = bflo(w.z); x[5] = bfhi(w.z); x[6] = bflo(w.w); x[7] = bfhi(w.w); }
__device__ __forceinline__ u32x4 pack8f(const float (&x)[8]) { u32x4 w; w.x = cvt_pk_bf16(x[0], x[1]); w.y = cvt_pk_bf16(x[2], x[3]); w.z = cvt_pk_bf16(x[4], x[5]); w.w = cvt_pk_bf16(x[6], x[7]); return w; }

__device__ __forceinline__ void mix_gmlp(const Args& args, int l, LAS unsigned char* lds, int unit, int tid) {
    const int c = unit >> 2, g = unit & 3, lane = tid & 63, w = __builtin_amdgcn_readfirstlane(tid >> 6), fr = lane & 15, fq = lane >> 4;
    const bf16_t* proj = (const bf16_t*)(args.ws + WS_PROJ); bf16_t* y = (bf16_t*)(args.ws + WS_Y);
    const float* g_v = args.in[I_GM_NORM_V] + l * 512; const float* b_s = args.in[I_GM_B_S] + l * 512;
    const bf16_t* WsB = (const bf16_t*)(args.ws + WS_SMALLW) + (size_t)(l * 4 + g) * 16384;
    LAS bf16_t* vt = (LAS bf16_t*)lds;
    const float* gvs = (const float*)(args.ws + WS_GVS);
    u32x4 rawv[4];
#pragma unroll
    for (int i = 0; i < 4; ++i) { const int idx = lane + 64 * i; rawv[i] = *(const u32x4*)(proj + ((size_t)c * 128 + 16 * w + (idx >> 4)) * PROJ_LD + 512 + g * 128 + 8 * (idx & 15)); }
    const int rt = 16 * w + fr; const size_t row = (size_t)c * 128 + rt;
    bf16x8 wsf[4]; u32x2 uraw[8];
#pragma unroll
    for (int ks = 0; ks < 4; ++ks) wsf[ks] = *(const bf16x8*)(WsB + rt * 128 + 32 * ks + 8 * fq);
#pragma unroll
    for (int nb = 0; nb < 8; ++nb) uraw[nb] = *(const u32x2*)(proj + row * PROJ_LD + g * 128 + 16 * nb + 4 * fq);
    const float bias = b_s[g * 128 + rt];
    LAS float* rtab = (LAS float*)(lds + 128 * TS * 2) + 16 * w;
    if (lane < 16) { const f32x4* p = (const f32x4*)(gvs + ((size_t)c * 128 + 16 * w + lane) * 8); const f32x4 a = p[0], b = p[1];
        rtab[lane] = rsqrtf((((a.x + a.y) + (a.z + a.w)) + ((b.x + b.y) + (b.z + b.w))) * (1.0f / 512.0f) + EPS); }
    LDS_WAIT();
#pragma unroll
    for (int i = 0; i < 4; ++i) { const int idx = lane + 64 * i, pr = idx >> 4, ck = idx & 15; const float rstd = rtab[pr];
        const f32x4 g0 = *(const f32x4*)(g_v + g * 128 + 8 * ck), g1 = *(const f32x4*)(g_v + g * 128 + 8 * ck + 4);
        float x[8]; unpack8(rawv[i], x);
#pragma unroll
        for (int j = 0; j < 4; ++j) { x[j] = gelu_tanh(x[j]) * rstd * g0[j]; x[4 + j] = gelu_tanh(x[4 + j]) * rstd * g1[j]; }
        *(LAS u32x4*)(vt + (16 * w + pr) * TS + 8 * ck) = pack8f(x); }
    __syncthreads();
    f32x4 acc[8];
#pragma unroll
    for (int nb = 0; nb < 8; ++nb) acc[nb] = (f32x4){0.f, 0.f, 0.f, 0.f};
#pragma unroll
    for (int ks = 0; ks < 4; ++ks) if (32 * ks <= 16 * w + 15) {
        const bf16x8 a = wsf[ks];
#pragma unroll
        for (int nb = 0; nb < 8; ++nb) { const bf16x8 b = tr_frag(vt, 32 * ks + 8 * fq, 32 * ks + 8 * fq + 4, 16 * nb, lane); acc[nb] = MFMA16(b, a, acc[nb]); } }
#pragma unroll
    for (int nb = 0; nb < 8; ++nb) { const int col = g * 128 + 16 * nb + 4 * fq; const u32x2 uu = uraw[nb];
        const float u0 = gelu_tanh(bflo(uu.x)), u1 = gelu_tanh(bfhi(uu.x)), u2 = gelu_tanh(bflo(uu.y)), u3 = gelu_tanh(bfhi(uu.y));
        u32x2 o; o.x = cvt_pk_bf16(u0 * (acc[nb][0] + bias), u1 * (acc[nb][1] + bias)); o.y = cvt_pk_bf16(u2 * (acc[nb][2] + bias), u3 * (acc[nb][3] + bias));
        *(u32x2*)(y + row * DM + col) = o; }
    __syncthreads();
}

constexpr int LRU_RAW = 0, LRU_XCB = 35840, LRU_A = 70656, LRU_BX = 103424, LRU_SEGA = 136192, LRU_SEGH = 138240, LRU_CARRY = 140288;
constexpr size_t LRU_HL = 0, LRU_PL = 16 * MiB;
__device__ __forceinline__ void mix_lru0(const Args& args, int l, LAS unsigned char* lds, int unit, int tid) {
    const int c = unit >> 2, g = unit & 3, lane = tid & 63, w = __builtin_amdgcn_readfirstlane(tid >> 6), fr = lane & 15, fq = lane >> 4, t0 = c * 128;
    const bf16_t* proj = (const bf16_t*)(args.ws + WS_PROJ);
    f32x2* AH = (f32x2*)(args.ws + WS_LRU_AH); float* HL = (float*)(args.ws + WS_NAIVE + LRU_HL); float* PL = (float*)(args.ws + WS_NAIVE + LRU_PL);
    const bf16_t* WT = (const bf16_t*)(args.ws + WS_SMALLW + 1 * MiB);
    const bf16_t* WrT = WT + (size_t)((l * 2 + 0) * 4 + g) * 16384; const bf16_t* WiT = WT + (size_t)((l * 2 + 1) * 4 + g) * 16384;
    const float* cw = args.in[I_LRU_CONV_W] + l * 4 * 512; const float* cb = args.in[I_LRU_CONV_B] + l * 512;
    const float* b_r = args.in[I_LRU_B_R] + l * 512; const float* b_i = args.in[I_LRU_B_I] + l * 512; const float* lam8 = (const float*)(args.ws + WS_SMALLW + 2 * MiB) + l * 512;
    LAS bf16_t* raw = (LAS bf16_t*)(lds + LRU_RAW); LAS bf16_t* xcb = (LAS bf16_t*)(lds + LRU_XCB);
    LAS float* Al = (LAS float*)(lds + LRU_A); LAS float* Bl = (LAS float*)(lds + LRU_BX);
    LAS float* segA = (LAS float*)(lds + LRU_SEGA); LAS float* segH = (LAS float*)(lds + LRU_SEGH);
    u32x4 wq[4];
#pragma unroll
    for (int i = 0; i < 4; ++i) { const int idx = tid + NTHREADS * i; wq[i] = *(const u32x4*)(((idx >> 10) ? WiT : WrT) + ((idx >> 4) & 63) * 128 + 8 * (idx & 15)); }
    for (int idx = tid; idx < 131 * 16; idx += NTHREADS) { const int r = idx >> 4, ck = idx & 15, t = t0 - 3 + r;
        u32x4 v = (u32x4){0u, 0u, 0u, 0u}; if (t >= 0) v = *(const u32x4*)(proj + (size_t)t * PROJ_LD + 2 * 512 + g * 128 + 8 * ck);
        *(LAS u32x4*)(raw + r * TS + 8 * ck) = v; }
    __syncthreads();
    for (int idx = tid; idx < 128 * 16; idx += NTHREADS) { const int t = idx >> 4, ck = idx & 15, ch0 = g * 128 + 8 * ck;
        float a8[8]; { const f32x4 c0 = *(const f32x4*)(cb + ch0), c1 = *(const f32x4*)(cb + ch0 + 4);
#pragma unroll
            for (int j = 0; j < 4; ++j) { a8[j] = c0[j]; a8[4 + j] = c1[j]; } }
#pragma unroll
        for (int k = 0; k < 4; ++k) { float x[8]; unpack8(*(const LAS u32x4*)(raw + (t + k) * TS + 8 * ck), x);
            const f32x4 w0 = *(const f32x4*)(cw + k * 512 + ch0), w1 = *(const f32x4*)(cw + k * 512 + ch0 + 4);
#pragma unroll
            for (int j = 0; j < 4; ++j) { a8[j] += w0[j] * x[j]; a8[4 + j] += w1[j] * x[4 + j]; } }
        *(LAS u32x4*)(xcb + t * TS + 8 * ck) = pack8f(a8); }
    __syncthreads();
    const int rt = 16 * w + fr;
#pragma unroll 1
    for (int hd = 0; hd < 2; ++hd) {
#pragma unroll
        for (int i = 0; i < 4; ++i) { const int idx = tid + NTHREADS * i; *(LAS u32x4*)(raw + (idx >> 4) * TS + 8 * (idx & 15)) = wq[i]; }
        if (hd == 0) {
#pragma unroll
            for (int i = 0; i < 4; ++i) { const int idx = tid + NTHREADS * i; wq[i] = *(const u32x4*)(((idx >> 10) ? WiT : WrT) + (64 + ((idx >> 4) & 63)) * 128 + 8 * (idx & 15)); } }
        __syncthreads();
        f32x4 aR[4], aI[4];
#pragma unroll
        for (int nb = 0; nb < 4; ++nb) { aR[nb] = (f32x4){0.f, 0.f, 0.f, 0.f}; aI[nb] = (f32x4){0.f, 0.f, 0.f, 0.f}; }
#pragma unroll
        for (int ks = 0; ks < 4; ++ks) { const bf16x8 a = *(const LAS bf16x8*)(xcb + rt * TS + 32 * ks + 8 * fq);
#pragma unroll
            for (int nb = 0; nb < 4; ++nb) {
                const bf16x8 bR = *(const LAS bf16x8*)(raw + (16 * nb + fr) * TS + 32 * ks + 8 * fq), bI = *(const LAS bf16x8*)(raw + (64 + 16 * nb + fr) * TS + 32 * ks + 8 * fq);
                aR[nb] = MFMA16(bR, a, aR[nb]); aI[nb] = MFMA16(bI, a, aI[nb]); } }
#pragma unroll
        for (int nb = 0; nb < 4; ++nb) { const int d0 = 64 * hd + 16 * nb + 4 * fq, ch = g * 128 + d0;
            const f32x4 br = *(const f32x4*)(b_r + ch), bi = *(const f32x4*)(b_i + ch), lm = *(const f32x4*)(lam8 + ch);
            const u32x2 xw = *(const LAS u32x2*)(xcb + rt * TS + d0); const float xc[4] = {bflo(xw.x), bfhi(xw.x), bflo(xw.y), bfhi(xw.y)};
            f32x4 av, bv;
#pragma unroll
            for (int j = 0; j < 4; ++j) { const float r = sigmoidf_(aR[nb][j] + br[j]), ii = sigmoidf_(aI[nb][j] + bi[j]);
                const float a = __builtin_amdgcn_exp2f(r * lm[j]); av[j] = a; bv[j] = __builtin_amdgcn_sqrtf(fmaxf(1.0f - a * a, 0.f)) * (ii * xc[j]); }
            *(LAS f32x4*)(Al + rt * 64 + 16 * nb + 4 * fq) = av; *(LAS f32x4*)(Bl + rt * 64 + 16 * nb + 4 * fq) = bv; }
        __syncthreads();
        float ap = 1.f, h = 0.f;
#pragma unroll
        for (int i = 0; i < 16; ++i) { const float a = Al[(16 * w + i) * 64 + lane], b = Bl[(16 * w + i) * 64 + lane]; h = a * h + b; ap *= a; }
        segA[w * 64 + lane] = ap; segH[w * 64 + lane] = h;
        __syncthreads();
        float hin = 0.f, pin = 1.f;
        for (int s = 0; s < w; ++s) { const float a = segA[s * 64 + lane]; hin = a * hin + segH[s * 64 + lane]; pin *= a; }
        const int chn = g * 128 + 64 * hd + lane;
#pragma unroll
        for (int i = 0; i < 16; ++i) { const int t = 16 * w + i; const float a = Al[t * 64 + lane], b = Bl[t * 64 + lane]; hin = a * hin + b; pin *= a;
            HL[(size_t)(t0 + t) * 512 + chn] = hin; PL[(size_t)(t0 + t) * 512 + chn] = pin; }
        if (w == 7) AH[(size_t)c * 512 + chn] = (f32x2){pin, hin};
        __syncthreads();
    }
}
__device__ __forceinline__ void mix_lru1(const Args& args, int l, LAS unsigned char* lds, int unit, int tid) {
    const int c = unit >> 2, g = unit & 3, t0 = c * 128;
    const bf16_t* proj = (const bf16_t*)(args.ws + WS_PROJ); bf16_t* y = (bf16_t*)(args.ws + WS_Y);
    const f32x2* AH = (const f32x2*)(args.ws + WS_LRU_AH); const float* HL = (const float*)(args.ws + WS_NAIVE + LRU_HL); const float* PL = (const float*)(args.ws + WS_NAIVE + LRU_PL);
    LAS float* carry = (LAS float*)(lds + LRU_CARRY);
    const int cq = tid & 31, r0 = tid >> 5, chn = g * 128 + 4 * cq;
    f32x4 hl[8], pl[8]; u32x2 gt[8];
#pragma unroll
    for (int i = 0; i < 8; ++i) { const size_t row = (size_t)t0 + 16 * i + r0; hl[i] = *(const f32x4*)(HL + row * 512 + chn); pl[i] = *(const f32x4*)(PL + row * 512 + chn); gt[i] = *(const u32x2*)(proj + row * PROJ_LD + 3 * 512 + chn); }
    { const int ch = tid & 127, part = tid >> 7; const f32x2* p = AH + g * 128 + ch; LAS f32x2* parts = (LAS f32x2*)(lds + LRU_CARRY + 512);
      f32x2 v[16];
#pragma unroll
      for (int i = 0; i < 16; ++i) v[i] = (part * 16 + i < c) ? p[(size_t)(part * 16 + i) * 512] : (f32x2){1.f, 0.f};
      float pa = 1.f, ph = 0.f;
#pragma unroll
      for (int i = 0; i < 16; ++i) { ph = v[i].x * ph + v[i].y; pa = v[i].x * pa; }
      parts[part * 128 + ch] = (f32x2){pa, ph}; }
    __syncthreads();
    if (tid < 128) { const LAS f32x2* parts = (const LAS f32x2*)(lds + LRU_CARRY + 512); float hc = 0.f;
#pragma unroll
        for (int q = 0; q < 4; ++q) { const f32x2 v = parts[q * 128 + tid]; hc = v.x * hc + v.y; }
        carry[tid] = hc; }
    __syncthreads();
    const f32x4 cy = *(const LAS f32x4*)(carry + 4 * cq);
#pragma unroll
    for (int i = 0; i < 8; ++i) { const size_t row = (size_t)t0 + 16 * i + r0; const f32x4 hv = hl[i] + pl[i] * cy;
        u32x2 o; o.x = cvt_pk_bf16(hv[0] * gelu_tanh(bflo(gt[i].x)), hv[1] * gelu_tanh(bfhi(gt[i].x))); o.y = cvt_pk_bf16(hv[2] * gelu_tanh(bflo(gt[i].y)), hv[3] * gelu_tanh(bfhi(gt[i].y)));
        *(u32x2*)(y + row * DM + 512 + chn) = o; }
    __syncthreads();
}
constexpr int AT_K = 0, AT_V = 17408, AT_KR = 34816, AT_DONE = 35072;
constexpr float AT_RMIN = -127.0f;
__device__ __forceinline__ void mix_attn(const Args& args, int l, LAS unsigned char* lds, int unit, int tid) {
    const int h = unit & 3, qt = unit >> 2, lane = tid & 63, w = __builtin_amdgcn_readfirstlane(tid >> 6), fr = lane & 15, fq = lane >> 4, q0 = qt * 128;
    const int trow = q0 + 16 * w + fr;
    const bf16_t* proj = (const bf16_t*)(args.ws + WS_PROJ); bf16_t* y = (bf16_t*)(args.ws + WS_Y);
    const float* g_q = args.in[I_SB_NORM_Q] + l * 128; const float* g_k = args.in[I_SB_NORM_K] + l * 128;
    LAS bf16_t* Kt = (LAS bf16_t*)(lds + AT_K); LAS bf16_t* Vt = (LAS bf16_t*)(lds + AT_V); LAS float* kr = (LAS float*)(lds + AT_KR); LAS unsigned* done = (LAS unsigned*)(lds + AT_DONE);
    u32x4 pk[2], pv[2];
#pragma unroll
    for (int i = 0; i < 2; ++i) { const int idx = tid + NTHREADS * i, r = idx >> 4, ck = idx & 15; const size_t s = (size_t)64 * (2 * qt + 1) + r;
        pk[i] = *(const u32x4*)(proj + s * PROJ_LD + 9 * 512 + h * 128 + 8 * ck); pv[i] = *(const u32x4*)(proj + s * PROJ_LD + 10 * 512 + h * 128 + 8 * ck); }
    bf16x8 qf[4];
    { float x[4][8]; float ss = 0.f;
#pragma unroll
      for (int ks = 0; ks < 4; ++ks) { unpack8(*(const u32x4*)(proj + (size_t)trow * PROJ_LD + 8 * 512 + h * 128 + 32 * ks + 8 * fq), x[ks]);
#pragma unroll
          for (int e = 0; e < 8; ++e) ss += x[ks][e] * x[ks][e]; }
      ss += __shfl_xor(ss, 16); ss += __shfl_xor(ss, 32);
      const float rstd = rsqrtf(ss * (1.0f / 128.0f) + EPS) * (0.08838834764831845f * 1.4426950408889634f);
#pragma unroll
      for (int ks = 0; ks < 4; ++ks) { const int d0 = 32 * ks + 8 * fq;
          const f32x4 a0 = *(const f32x4*)(g_q + d0), a1 = *(const f32x4*)(g_q + d0 + 4), b0 = *(const f32x4*)(g_k + d0), b1 = *(const f32x4*)(g_k + d0 + 4);
#pragma unroll
          for (int e = 0; e < 4; ++e) { x[ks][e] *= rstd * a0[e] * b0[e]; x[ks][4 + e] *= rstd * a1[e] * b1[e]; }
          qf[ks] = __builtin_bit_cast(bf16x8, pack8f(x[ks])); } }
    f32x4 o[8];
#pragma unroll
    for (int db = 0; db < 8; ++db) o[db] = (f32x4){0.f, 0.f, 0.f, 0.f};
    float R = 0.f; bool mydone = false;
    for (int kt = 2 * qt + 1; kt >= 0; --kt) {
#pragma unroll
        for (int i = 0; i < 2; ++i) { const int idx = tid + NTHREADS * i, r = idx >> 4, ck = idx & 15;
            *(LAS u32x4*)(Kt + r * TS + 8 * ck) = pk[i]; *(LAS u32x4*)(Vt + r * TS + 8 * ck) = pv[i];
            float x[8]; unpack8(pk[i], x); float ss = 0.f;
#pragma unroll
            for (int e = 0; e < 8; ++e) ss += x[e] * x[e];
            ss += __shfl_xor(ss, 1); ss += __shfl_xor(ss, 2); ss += __shfl_xor(ss, 4); ss += __shfl_xor(ss, 8);
            if (ck == 0) kr[r] = rsqrtf(ss * (1.0f / 128.0f) + EPS); }
        if (kt > 0) {
#pragma unroll
            for (int i = 0; i < 2; ++i) { const int idx = tid + NTHREADS * i, r = idx >> 4, ck = idx & 15; const size_t s = (size_t)64 * (kt - 1) + r;
                pk[i] = *(const u32x4*)(proj + s * PROJ_LD + 9 * 512 + h * 128 + 8 * ck); pv[i] = *(const u32x4*)(proj + s * PROJ_LD + 10 * 512 + h * 128 + 8 * ck); } }
        __syncthreads();
        const bool active = !mydone && (64 * kt < q0 + 16 * w + 15);
        if (active) {
            f32x4 s4[4];
#pragma unroll
            for (int nb = 0; nb < 4; ++nb) s4[nb] = (f32x4){0.f, 0.f, 0.f, 0.f};
#pragma unroll
            for (int ks = 0; ks < 4; ++ks)
#pragma unroll
                for (int nb = 0; nb < 4; ++nb) { const bf16x8 cf = *(const LAS bf16x8*)(Kt + (16 * nb + fr) * TS + 32 * ks + 8 * fq); s4[nb] = MFMA16(cf, qf[ks], s4[nb]); }
            float ln[4][4], zz[4][4], RT[4], sfq[4];
#pragma unroll
            for (int nb = 0; nb < 4; ++nb) { const f32x4 k4 = *(const LAS f32x4*)(kr + 16 * nb + 4 * fq); float gs = 0.f;
#pragma unroll
                for (int j = 0; j < 4; ++j) { const int s = 64 * kt + 16 * nb + 4 * fq + j; const bool valid = s < trow; const float z = s4[nb][j] * k4[j];
                    const float sp = fmaxf(z, 0.f) + __builtin_amdgcn_logf(1.0f + __builtin_amdgcn_exp2f(-fabsf(z)));
                    ln[nb][j] = valid ? -sp : 0.f; zz[nb][j] = valid ? z : -1.0e30f; gs += ln[nb][j]; }
                const float b = __shfl_xor(gs, 16); const float pair = gs + b; const float po = __shfl_xor(pair, 32);
                RT[nb] = pair + po; sfq[nb] = ((fq & 1) ? 0.f : b) + ((fq & 2) ? 0.f : po); }
            float att[4][4]; float above = 0.f;
#pragma unroll
            for (int nb = 3; nb >= 0; --nb) { float rem = R + above + sfq[nb];
#pragma unroll
                for (int j = 3; j >= 0; --j) { att[nb][j] = __builtin_amdgcn_exp2f(zz[nb][j] + ln[nb][j] + rem); rem += ln[nb][j]; }
                above += RT[nb]; }
            R += above;
#pragma unroll
            for (int ksv = 0; ksv < 2; ++ksv) { u32x4 pw; pw.x = cvt_pk_bf16(att[2 * ksv][0], att[2 * ksv][1]); pw.y = cvt_pk_bf16(att[2 * ksv][2], att[2 * ksv][3]);
                pw.z = cvt_pk_bf16(att[2 * ksv + 1][0], att[2 * ksv + 1][1]); pw.w = cvt_pk_bf16(att[2 * ksv + 1][2], att[2 * ksv + 1][3]);
                const bf16x8 rf = __builtin_bit_cast(bf16x8, pw);
#pragma unroll
                for (int db = 0; db < 8; ++db) { const bf16x8 cf = tr_frag(Vt, 32 * ksv + 4 * fq, 32 * ksv + 16 + 4 * fq, 16 * db, lane); o[db] = MFMA16(cf, rf, o[db]); } }
            mydone = __all(R < AT_RMIN);
        }
        if (lane == 0) done[w] = mydone ? 1u : 0u;
        __syncthreads();
        unsigned alld = 1u;
#pragma unroll
        for (int i = 0; i < 8; ++i) alld &= done[i];
        if (alld) break;
    }
#pragma unroll
    for (int db = 0; db < 8; ++db) { u32x2 ov; ov.x = cvt_pk_bf16(o[db][0], o[db][1]); ov.y = cvt_pk_bf16(o[db][2], o[db][3]);
        *(u32x2*)(y + (size_t)trow * DM + 1536 + h * 128 + 16 * db + 4 * fq) = ov; }
    __syncthreads();
}

constexpr size_t ML_DC = 0, ML_CP = 16 * MiB, ML_DN = 24 * MiB, ML_NP = 24 * MiB + 256 * 1024, ML_SC = 24 * MiB + 512 * 1024;
struct ConvRaw { u32x4 v[5]; };
__device__ __forceinline__ void conv_load(ConvRaw& R, const bf16_t* proj, int col0, int t0, int tid) {
#pragma unroll
    for (int i = 0; i < 5; ++i) { const int idx = tid + NTHREADS * i, r = idx >> 4, ck = idx & 15, t = t0 - 3 + r;
        R.v[i] = (u32x4){0u, 0u, 0u, 0u}; if (idx < 131 * 16 && t >= 0) R.v[i] = *(const u32x4*)(proj + (size_t)t * PROJ_LD + col0 + 8 * ck); }
}
__device__ __forceinline__ void conv_tile(const ConvRaw& R, const float* cw, int cwstride, const float* cb, LAS bf16_t* raw, LAS bf16_t* outt, float post, int tid) {
#pragma unroll
    for (int i = 0; i < 5; ++i) { const int idx = tid + NTHREADS * i, r = idx >> 4, ck = idx & 15; if (idx < 131 * 16) *(LAS u32x4*)(raw + r * TS + 8 * ck) = R.v[i]; }
    __syncthreads();
    for (int idx = tid; idx < 128 * 16; idx += NTHREADS) { const int t = idx >> 4, ck = idx & 15;
        float a8[8]; { const f32x4 c0 = *(const f32x4*)(cb + 8 * ck), c1 = *(const f32x4*)(cb + 8 * ck + 4);
#pragma unroll
            for (int j = 0; j < 4; ++j) { a8[j] = c0[j]; a8[4 + j] = c1[j]; } }
#pragma unroll
        for (int k = 0; k < 4; ++k) { float x[8]; unpack8(*(const LAS u32x4*)(raw + (t + k) * TS + 8 * ck), x);
            const f32x4 w0 = *(const f32x4*)(cw + k * cwstride + 8 * ck), w1 = *(const f32x4*)(cw + k * cwstride + 8 * ck + 4);
#pragma unroll
            for (int j = 0; j < 4; ++j) { a8[j] += w0[j] * x[j]; a8[4 + j] += w1[j] * x[4 + j]; } }
#pragma unroll
        for (int j = 0; j < 8; ++j) a8[j] = a8[j] * sigmoidf_(a8[j]) * post;
        *(LAS u32x4*)(outt + t * TS + 8 * ck) = pack8f(a8); }
    __syncthreads();
}
constexpr int ML_RAW = 0, ML_T1 = 35840, ML_T2 = 70656, ML_T3 = 105472, ML_ARR = 140288;
__device__ __forceinline__ void mix_ml1(const Args& args, int l, LAS unsigned char* lds, int unit, int tid) {
    const int c = unit >> 2, h = unit & 3, lane = tid & 63, w = __builtin_amdgcn_readfirstlane(tid >> 6), fr = lane & 15, fq = lane >> 4, t0 = c * 128;
    const bf16_t* proj = (const bf16_t*)(args.ws + WS_PROJ); const float* ifg = (const float*)(args.ws + WS_IFG);
    unsigned char* ml = args.ws + WS_ML; float* dC = (float*)(ml + ML_DC); float* dn = (float*)(ml + ML_DN); float* scal = (float*)(ml + ML_SC);
    LAS bf16_t* raw = (LAS bf16_t*)(lds + ML_RAW); LAS bf16_t* KC = (LAS bf16_t*)(lds + ML_T1); LAS bf16_t* VW = (LAS bf16_t*)(lds + ML_T2); LAS float* wl = (LAS float*)(lds + ML_ARR);
    ConvRaw kraw; conv_load(kraw, proj, 5 * 512 + h * 128, t0, tid);
    u32x4 vraw[4];
#pragma unroll
    for (int i = 0; i < 4; ++i) { const int idx = tid + NTHREADS * i, s = idx >> 4, ck = idx & 15; vraw[i] = *(const u32x4*)(proj + (size_t)(t0 + s) * PROJ_LD + 6 * 512 + h * 128 + 8 * ck); }
    if (w == 0) { const float bf = args.in[I_ML_B_F][l * 4 + h], bi = args.in[I_ML_B_I][l * 4 + h]; const int s0 = t0 + 2 * lane;
        const float f0 = logsigf_(ifg[(size_t)s0 * 8 + 4 + h] + bf), f1 = logsigf_(ifg[(size_t)(s0 + 1) * 8 + 4 + h] + bf);
        const float i0 = ifg[(size_t)s0 * 8 + h] + bi, i1 = ifg[(size_t)(s0 + 1) * 8 + h] + bi;
        float P = f0 + f1;
#pragma unroll
        for (int o = 1; o < 64; o <<= 1) { const float n = __shfl_up(P, o); if (lane >= o) P += n; }
        const float blast = __shfl(P, 63); const float g0 = blast - (P - f1) + i0, g1 = blast - P + i1;
        float m = fmaxf(g0, g1);
#pragma unroll
        for (int o = 1; o < 64; o <<= 1) m = fmaxf(m, __shfl_xor(m, o));
        wl[2 * lane] = __expf(g0 - m); wl[2 * lane + 1] = __expf(g1 - m);
        if (lane == 0) { scal[(c * 4 + h) * 4 + 0] = blast; scal[(c * 4 + h) * 4 + 1] = m; } }
    conv_tile(kraw, args.in[I_ML_CONV_W] + l * 4 * 1024 + 512 + h * 128, 1024, args.in[I_ML_CONV_B] + l * 1024 + 512 + h * 128, raw, KC, 0.08838834764831845f, tid);
#pragma unroll
    for (int i = 0; i < 4; ++i) { const int idx = tid + NTHREADS * i, s = idx >> 4, ck = idx & 15; float x[8]; unpack8(vraw[i], x);
        const float ws_ = wl[s];
#pragma unroll
        for (int j = 0; j < 8; ++j) x[j] *= ws_;
        *(LAS u32x4*)(VW + s * TS + 8 * ck) = pack8f(x); }
    __syncthreads();
    f32x4 acc[8];
#pragma unroll
    for (int nb = 0; nb < 8; ++nb) acc[nb] = (f32x4){0.f, 0.f, 0.f, 0.f};
#pragma unroll
    for (int ks = 0; ks < 4; ++ks) { const bf16x8 rf = tr_frag(VW, 32 * ks + 8 * fq, 32 * ks + 8 * fq + 4, 16 * w, lane);
#pragma unroll
        for (int nb = 0; nb < 8; ++nb) { const bf16x8 cf = tr_frag(KC, 32 * ks + 8 * fq, 32 * ks + 8 * fq + 4, 16 * nb, lane); acc[nb] = MFMA16(cf, rf, acc[nb]); } }
    float* dCu = dC + (size_t)(c * 4 + h) * 16384 + (16 * w + fr) * 128 + 4 * fq;
#pragma unroll
    for (int nb = 0; nb < 8; ++nb) *(f32x4*)(dCu + 16 * nb) = acc[nb];
    if (tid < 128) { float s = 0.f;
        for (int ss = 0; ss < 128; ++ss) s += wl[ss] * bf2f(KC[ss * TS + tid]);
        dn[(size_t)(c * 4 + h) * 128 + tid] = s; }
    __syncthreads();
}
__device__ __forceinline__ void mix_ml2(const Args& args, LAS unsigned char* lds, int b, int tid) {
    const int h = b >> 6, sl = b & 63, lane = tid & 63;
    unsigned char* ml = args.ws + WS_ML; const float* dC = (const float*)(ml + ML_DC); unsigned* Cp = (unsigned*)(ml + ML_CP); const float* dn = (const float*)(ml + ML_DN); float* np = (float*)(ml + ML_NP); float* scal = (float*)(ml + ML_SC);
    LAS float* decl = (LAS float*)lds; LAS float* scl = decl + 64;
    const bool ethr = tid < 128; const int e = sl * 256 + (ethr ? tid : 0) * 2; const bool nthr = (sl == 0 && tid < 128);
    f32x2 d[16]; float dnv[16];
#pragma unroll
    for (int i = 0; i < 16; ++i) { const int u = i * 4 + h; d[i] = *(const f32x2*)(dC + (size_t)u * 16384 + e); dnv[i] = nthr ? dn[(size_t)u * 128 + tid] : 0.f; }
    if (tid < 64) { const int u = lane * 4 + h; const float bl = scal[u * 4 + 0], mlc = scal[u * 4 + 1]; float m = 0.f, mydec = 0.f, mysc = 0.f, mym = 0.f;
#pragma unroll
        for (int c = 0; c < 64; ++c) { const float blc = __builtin_bit_cast(float, __builtin_amdgcn_readlane(__builtin_bit_cast(int, bl), c)), mc = __builtin_bit_cast(float, __builtin_amdgcn_readlane(__builtin_bit_cast(int, mlc), c));
            const float mnew = fmaxf(blc + m, mc); const float dec = __expf(blc + m - mnew), sc = __expf(mc - mnew);
            if (lane == c) { mydec = dec; mysc = sc; mym = m; }
            m = mnew; }
        decl[lane] = mydec; scl[lane] = mysc; if (sl == 0) scal[u * 4 + 2] = mym; }
    __syncthreads();
    float C0 = 0.f, C1 = 0.f, n = 0.f;
#pragma unroll 1
    for (int c0 = 0; c0 < 64; c0 += 16) {
        f32x2 dn_[16]; float dnn[16];
        if (c0 + 16 < 64) {
#pragma unroll
            for (int i = 0; i < 16; ++i) { const int u = (c0 + 16 + i) * 4 + h; dn_[i] = *(const f32x2*)(dC + (size_t)u * 16384 + e); dnn[i] = nthr ? dn[(size_t)u * 128 + tid] : 0.f; } }
#pragma unroll
        for (int i = 0; i < 16; ++i) { const int u = (c0 + i) * 4 + h; const float dec = decl[c0 + i], sc = scl[c0 + i];
            if (ethr) Cp[((size_t)u * 16384 + e) >> 1] = cvt_pk_bf16(C0, C1);
            if (nthr) np[(size_t)u * 128 + tid] = n;
            C0 = dec * C0 + sc * d[i].x; C1 = dec * C1 + sc * d[i].y; n = dec * n + sc * dnv[i]; }
#pragma unroll
        for (int i = 0; i < 16; ++i) { d[i] = dn_[i]; dnv[i] = dnn[i]; }
    }
    __syncthreads();
}
__device__ __forceinline__ void mix_ml3(const Args& args, int l, LAS unsigned char* lds, int unit, int tid) {
    const int c = unit >> 2, h = unit & 3, lane = tid & 63, w = __builtin_amdgcn_readfirstlane(tid >> 6), fr = lane & 15, fq = lane >> 4, t0 = c * 128;
    const bf16_t* proj = (const bf16_t*)(args.ws + WS_PROJ); const float* ifg = (const float*)(args.ws + WS_IFG); bf16_t* y = (bf16_t*)(args.ws + WS_Y);
    unsigned char* ml = args.ws + WS_ML; const bf16_t* Cp = (const bf16_t*)(ml + ML_CP) + (size_t)(c * 4 + h) * 16384; const float* npv = (const float*)(ml + ML_NP) + (size_t)(c * 4 + h) * 128; const float* scal = (const float*)(ml + ML_SC);
    LAS bf16_t* raw = (LAS bf16_t*)(lds + ML_RAW); LAS bf16_t* QC = (LAS bf16_t*)(lds + ML_T1); LAS bf16_t* KC = (LAS bf16_t*)(lds + ML_T2); LAS bf16_t* VT = (LAS bf16_t*)(lds + ML_T3);
    LAS float* bcl = (LAS float*)(lds + ML_ARR); LAS float* gil = bcl + 128; LAS float* mtl = bcl + 256; LAS float* scl = bcl + 384; LAS float* npl = bcl + 512;
    ConvRaw qraw, kraw; conv_load(qraw, proj, 4 * 512 + h * 128, t0, tid); conv_load(kraw, proj, 5 * 512 + h * 128, t0, tid);
    u32x4 vraw[4];
#pragma unroll
    for (int i = 0; i < 4; ++i) { const int idx = tid + NTHREADS * i, s = idx >> 4, ck = idx & 15; vraw[i] = *(const u32x4*)(proj + (size_t)(t0 + s) * PROJ_LD + 6 * 512 + h * 128 + 8 * ck); }
    u32x4 cpr[4]; u32x2 opre[8];
#pragma unroll
    for (int i = 0; i < 4; ++i) { const int idx = tid + NTHREADS * i; cpr[i] = *(const u32x4*)(Cp + (idx >> 4) * 128 + 8 * (idx & 15)); }
#pragma unroll
    for (int db = 0; db < 8; ++db) opre[db] = *(const u32x2*)(proj + ((size_t)t0 + 16 * w + fr) * PROJ_LD + 7 * 512 + h * 128 + 16 * db + 4 * fq);
    if (w == 0) { const float bf = args.in[I_ML_B_F][l * 4 + h], bi = args.in[I_ML_B_I][l * 4 + h]; const int s0 = t0 + 2 * lane; const float mprev = scal[(c * 4 + h) * 4 + 2];
        const float f0 = logsigf_(ifg[(size_t)s0 * 8 + 4 + h] + bf), f1 = logsigf_(ifg[(size_t)(s0 + 1) * 8 + 4 + h] + bf);
        const float i0 = ifg[(size_t)s0 * 8 + h] + bi, i1 = ifg[(size_t)(s0 + 1) * 8 + h] + bi;
        float P = f0 + f1;
#pragma unroll
        for (int o = 1; o < 64; o <<= 1) { const float nn = __shfl_up(P, o); if (lane >= o) P += nn; }
        const float bc0 = P - f1, bc1 = P, gi0 = i0 - bc0, gi1 = i1 - bc1;
        float PM = fmaxf(gi0, gi1);
#pragma unroll
        for (int o = 1; o < 64; o <<= 1) { const float nn = __shfl_up(PM, o); if (lane >= o) PM = fmaxf(PM, nn); }
        float pe = __shfl_up(PM, 1); if (lane == 0) pe = -3.0e38f;
        const float M0 = fmaxf(pe, gi0), M1 = PM;
        const float m0 = fmaxf(bc0 + mprev, bc0 + M0), m1 = fmaxf(bc1 + mprev, bc1 + M1);
        bcl[2 * lane] = bc0; bcl[2 * lane + 1] = bc1; gil[2 * lane] = gi0; gil[2 * lane + 1] = gi1; mtl[2 * lane] = m0; mtl[2 * lane + 1] = m1;
        scl[2 * lane] = __expf(bc0 + mprev - m0); scl[2 * lane + 1] = __expf(bc1 + mprev - m1); }
    if (tid >= 128 && tid < 256) npl[tid - 128] = npv[tid - 128];
    conv_tile(qraw, args.in[I_ML_CONV_W] + l * 4 * 1024 + h * 128, 1024, args.in[I_ML_CONV_B] + l * 1024 + h * 128, raw, QC, 1.0f, tid);
    conv_tile(kraw, args.in[I_ML_CONV_W] + l * 4 * 1024 + 512 + h * 128, 1024, args.in[I_ML_CONV_B] + l * 1024 + 512 + h * 128, raw, KC, 0.08838834764831845f, tid);
#pragma unroll
    for (int i = 0; i < 4; ++i) { const int idx = tid + NTHREADS * i, s = idx >> 4, ck = idx & 15; *(LAS u32x4*)(VT + s * TS + 8 * ck) = vraw[i]; }
#pragma unroll
    for (int i = 0; i < 4; ++i) { const int idx = tid + NTHREADS * i; *(LAS u32x4*)(raw + (idx >> 4) * TS + 8 * (idx & 15)) = cpr[i]; }
    __syncthreads();
    const int tl = 16 * w + fr;
    bf16x8 qf[4];
#pragma unroll
    for (int ks = 0; ks < 4; ++ks) qf[ks] = *(const LAS bf16x8*)(QC + tl * TS + 32 * ks + 8 * fq);
    float pv[8][4]; float rs = 0.f; const float bt = bcl[tl] - mtl[tl];
#pragma unroll
    for (int nb = 0; nb < 8; ++nb) { f32x4 s4 = (f32x4){0.f, 0.f, 0.f, 0.f};
        if (nb <= w) {
#pragma unroll
            for (int ks = 0; ks < 4; ++ks) { const bf16x8 cf = *(const LAS bf16x8*)(KC + (16 * nb + fr) * TS + 32 * ks + 8 * fq); s4 = MFMA16(cf, qf[ks], s4); }
            const f32x4 g4 = *(const LAS f32x4*)(gil + 16 * nb + 4 * fq);
#pragma unroll
            for (int j = 0; j < 4; ++j) { const int s = 16 * nb + 4 * fq + j; const float p = (s <= tl) ? s4[j] * __expf(bt + g4[j]) : 0.f; pv[nb][j] = p; rs += p; }
        } else {
#pragma unroll
            for (int j = 0; j < 4; ++j) pv[nb][j] = 0.f; } }
    rs += __shfl_xor(rs, 16); rs += __shfl_xor(rs, 32);
    f32x4 n1[8], n2[8];
#pragma unroll
    for (int db = 0; db < 8; ++db) { n1[db] = (f32x4){0.f, 0.f, 0.f, 0.f}; n2[db] = (f32x4){0.f, 0.f, 0.f, 0.f}; }
#pragma unroll
    for (int ksv = 0; ksv < 4; ++ksv) if (2 * ksv <= w) { u32x4 pw; pw.x = cvt_pk_bf16(pv[2 * ksv][0], pv[2 * ksv][1]); pw.y = cvt_pk_bf16(pv[2 * ksv][2], pv[2 * ksv][3]);
        pw.z = cvt_pk_bf16(pv[2 * ksv + 1][0], pv[2 * ksv + 1][1]); pw.w = cvt_pk_bf16(pv[2 * ksv + 1][2], pv[2 * ksv + 1][3]);
        const bf16x8 rf = __builtin_bit_cast(bf16x8, pw);
#pragma unroll
        for (int db = 0; db < 8; ++db) { const bf16x8 cf = tr_frag(VT, 32 * ksv + 4 * fq, 32 * ksv + 16 + 4 * fq, 16 * db, lane); n1[db] = MFMA16(cf, rf, n1[db]); } }
#pragma unroll
    for (int ks = 0; ks < 4; ++ks)
#pragma unroll
        for (int db = 0; db < 8; ++db) { const bf16x8 cf = *(const LAS bf16x8*)(raw + (16 * db + fr) * TS + 32 * ks + 8 * fq); n2[db] = MFMA16(cf, qf[ks], n2[db]); }
    float d2 = 0.f;
#pragma unroll
    for (int ks = 0; ks < 4; ++ks) { float x[8]; unpack8(__builtin_bit_cast(u32x4, qf[ks]), x); const f32x4 a0 = *(const LAS f32x4*)(npl + 32 * ks + 8 * fq), a1 = *(const LAS f32x4*)(npl + 32 * ks + 8 * fq + 4);
#pragma unroll
        for (int e = 0; e < 4; ++e) d2 += x[e] * a0[e] + x[4 + e] * a1[e]; }
    d2 += __shfl_xor(d2, 16); d2 += __shfl_xor(d2, 32);
    const float sct = scl[tl]; const float den = rs + sct * d2; const float dnm = fmaxf(fabsf(den), __expf(-mtl[tl])); const float inv = 1.0f / dnm;
    float ss = 0.f;
#pragma unroll
    for (int db = 0; db < 8; ++db)
#pragma unroll
        for (int j = 0; j < 4; ++j) { const float hv = (n1[db][j] + sct * n2[db][j]) * inv; n1[db][j] = hv; ss += hv * hv; }
    ss += __shfl_xor(ss, 16); ss += __shfl_xor(ss, 32);
    const float rstd = rsqrtf(ss * (1.0f / 128.0f) + EPS);
    const float* g_h = args.in[I_ML_NORM_H] + l * 512 + h * 128; const size_t row = (size_t)t0 + tl;
#pragma unroll
    for (int db = 0; db < 8; ++db) { const int v = 16 * db + 4 * fq; const f32x4 gh = *(const f32x4*)(g_h + v); const u32x2 ow = opre[db];
        u32x2 ov; ov.x = cvt_pk_bf16(sigmoidf_(bflo(ow.x)) * n1[db][0] * rstd * gh[0], sigmoidf_(bfhi(ow.x)) * n1[db][1] * rstd * gh[1]);
        ov.y = cvt_pk_bf16(sigmoidf_(bflo(ow.y)) * n1[db][2] * rstd * gh[2], sigmoidf_(bfhi(ow.y)) * n1[db][3] * rstd * gh[3]);
        *(u32x2*)(y + row * DM + 1024 + h * 128 + v) = ov; }
    __syncthreads();
}
#ifndef REP_U1
#define REP_U1 1
#endif
#ifndef REP_U2
#define REP_U2 1
#endif
#ifndef REP_U3
#define REP_U3 1
#endif
#define MIX_PRE() int l = l_; asm volatile("" : "+s"(l)); int tid_m = threadIdx.x; asm volatile("" : "+v"(tid_m))
#define MIXER_PHASE_1 do { MIX_PRE(); \
    TP_BEGIN(11); for (int r_ = 0; r_ < REP_U1; ++r_) for (int u = vb; u < 256; u += G) mix_ml1(args, l, lds, u, tid_m); TP_END(11); \
    TP_BEGIN(12); for (int r_ = 0; r_ < REP_U2; ++r_) for (int u = vb; u < 256; u += G) mix_lru0(args, l, lds, u, tid_m); TP_END(12); \
    TP_BEGIN(13); for (int r_ = 0; r_ < REP_U3; ++r_) for (int u = vb; u < 256; u += G) mix_gmlp(args, l, lds, u, tid_m); TP_END(13); \
  } while (0)
#define MIXER_PHASE_2 do { MIX_PRE(); \
    TP_BEGIN(14); for (int u = vb; u < 256; u += G) mix_ml2(args, lds, u, tid_m); TP_END(14); \
    TP_BEGIN(15); for (int u = vb; u < 256; u += G) mix_attn(args, l, lds, u, tid_m); TP_END(15); \
    for (int u = vb; u < 256; u += G) mix_lru1(args, l, lds, u, tid_m); \
  } while (0)
#define MIXER_PHASE_3 do { MIX_PRE(); \
    for (int u = vb; u < 256; u += G) mix_ml3(args, l, lds, u, tid_m); \
  } while (0)
#ifndef PH_EN_P
#define PH_EN_P 1
#endif
#ifndef PH_EN_A
#define PH_EN_A 1
#endif
#ifndef PH_EN_C
#define PH_EN_C 1
#endif
#ifndef PH_EN_D
#define PH_EN_D 1
#endif
#ifndef PH_EN_E
#define PH_EN_E 1
#endif
#ifndef PH_EN_F
#define PH_EN_F 1
#endif
#ifndef XCC_LOCAL_SEAMS
#define XCC_LOCAL_SEAMS 1
#endif
__device__ __forceinline__ void xcc_local_barrier(unsigned* ctl, unsigned x, unsigned nloc, unsigned* nbw = nullptr, unsigned need = 0u) {
    asm volatile("s_waitcnt vmcnt(0)" ::: "memory");
    __syncthreads();
    if (threadIdx.x == 0) {
        __builtin_amdgcn_s_waitcnt(0);
        const unsigned old = xb_add(&ctl[12288 + 64 * x], 1u), gen = old / nloc;
        if (old + 1u == (gen + 1u) * nloc) { if (nbw) XB_SPIN(xb_ld(nbw) < need, ctl + 4096); xb_add(&ctl[13312 + 64 * x], 1u); }
        else XB_SPIN(xb_ld(&ctl[13312 + 64 * x]) == gen, ctl + 4096);
        __builtin_amdgcn_fence(__ATOMIC_ACQUIRE, "agent");
        asm volatile("s_waitcnt vmcnt(0)" ::: "memory");
    }
    __syncthreads();
}
constexpr int N_PHASES = 1 + 8 * DEPTH;
__global__ void __launch_bounds__(NTHREADS, 2) mk_fwd(Args args) {
    extern __shared__ __attribute__((aligned(16))) unsigned char lds_raw[];
    LAS unsigned char* lds = (LAS unsigned char*)lds_raw;
    const int tid = threadIdx.x, lane = tid & 63, wave = __builtin_amdgcn_readfirstlane(tid >> 6);
    const int G = gridDim.x; const int bx = blockIdx.x; const int vcu = (G % 8 == 0) ? (bx % 8) * (G / 8) + bx / 8 : bx;
    if (tid < 16) ((LAS unsigned*)(lds + LDS_MISC))[tid] = 0u;
    __syncthreads();
    unsigned* barw = (unsigned*)(args.ws + WS_CTL) + 4096;
    XcdBarrier bar = xcd_barrier_post(barw, (volatile LAS unsigned*)(lds + LDS_MISC));
    unsigned* ctlw = (unsigned*)(args.ws + WS_CTL);
    if (tid == 0) ((volatile LAS unsigned*)(lds + LDS_MISC))[4] = xb_add(&ctlw[10240 + 64 * bar.x], 1u);
    const Args& P = args;
    const int lo = args.ph_lo, hi = args.ph_hi;
#define IN(k) (lo <= (k) && (k) < hi)
#define BOTH(k) (IN(k) && IN((k) + 1))
#define SEAM(k) do { if (BOTH(k)) { TP_BEGIN(9); TP_BEGIN(20 + (((k) + 7) & 7)); xcd_barrier(bar); TP_END(20 + (((k) + 7) & 7)); TP_END(9); } } while (0)
#ifdef TPROBE
    unsigned long long tp_t0 = 0; unsigned tp_sum = 0;
#endif
#if defined(TPROBE) && TPROBE == 30
    if (threadIdx.x == 0) ((unsigned long long*)(args.ws + WS_CTL + 256 * 1024))[blockIdx.x] = __builtin_amdgcn_s_memrealtime();
#endif
    TP_BEGIN(10);
    if (PH_EN_P && IN(0)) { TP_BEGIN(0); for (int rep = 0; rep < REP_P; ++rep) p0_prologue(P, lds, vcu, G, wave, lane); TP_END(0); SEAM(0); }
#define WSP(T, off) ((T*)(wsb + (off)))
#define OPAQUE_WS() size_t opq_ = 0; asm volatile("" : "+s"(opq_)); unsigned char* wsb = args.ws + opq_; int l = l_; asm volatile("" : "+s"(l)); unsigned char* wl = wsb + WS_W + (size_t)l * WL_STRIDE
    int cid = bx; bool xcc_ok = false;
    if (BOTH(0)) {
        if (tid == 0) { bool ok = (G == 256);
            for (unsigned j = 0; j < 16; ++j) { const unsigned cnt = xb_ld(&ctlw[10240 + 64 * j]); ok = ok && (cnt == (j < 8 ? 32u : 0u)); }
            ((volatile LAS unsigned*)(lds + LDS_MISC))[5] = ok ? 1u : 0u; }
        __syncthreads();
        xcc_ok = ((volatile LAS unsigned*)(lds + LDS_MISC))[5] != 0u;
        if (xcc_ok) cid = (int)(((volatile LAS unsigned*)(lds + LDS_MISC))[4] * 8u + bar.x);
    }
    cid = __builtin_amdgcn_readfirstlane(cid);
    int vb = xcc_ok ? ((cid & 7) * 32 + (cid >> 3)) : bx; vb = __builtin_amdgcn_readfirstlane(vb);
#define SEAM_L(k) do { if (BOTH(k)) { TP_BEGIN(9); if (xcc_ok && XCC_LOCAL_SEAMS) xcc_local_barrier(ctlw, bar.x, 32u); else xcd_barrier(bar); TP_END(9); } } while (0)
#define SEAM_LG(k, need) do { if (BOTH(k)) { TP_BEGIN(9); if (xcc_ok && XCC_LOCAL_SEAMS) xcc_local_barrier(ctlw, bar.x, 32u, bar.x < 7u ? &ctlw[13312 + 64 * (bar.x + 1u)] : nullptr, (need)); else xcd_barrier(bar); TP_END(9); } } while (0)
    for (int l_ = 0; l_ < DEPTH; ++l_) {
        const int pb = 1 + 8 * l_;
        if (PH_EN_A && IN(pb + 0)) {
            TP_BEGIN(1); OPAQUE_WS();
            pg8::Gemm g{WSP(bf16_t, WS_XB), (const bf16_t*)(wl + WL_A), SEQ, NA, DM}; GEMM_ORDER S; S.init(SEQ, NA, G, cid);
            EpiA E{WSP(float, WS_STATS), WSP(bf16_t, WS_PROJ), WSP(float, WS_IFG), WSP(unsigned char, WS_GATES), args.in[I_B_GATE] + (size_t)l * 4 * DM, WSP(float, WS_GVS)};
            for (int rep = 0; rep < REP_A; ++rep) pg8::gemm_phase<EpiA, GEMM_ORDER>(lds, g, S, E);
            if (l + 1 < DEPTH && bx >= 224) { int ln = threadIdx.x & 63; asm volatile("" : "+v"(ln)); cvt_tail(args, l + 1, CV_TAIL_E, 32 * NWAVES, CV_A_PW, (bx - 224) * NWAVES + wave, lds, wave, ln); }
            TP_END(1); SEAM(pb + 0);
        }
        if (IN(pb + 1)) { TP_BEGIN(2); for (int rep = 0; rep < REP_M1; ++rep) { MIXER_PHASE_1; } TP_END(2); SEAM(pb + 1); }
        if (IN(pb + 2)) { TP_BEGIN(3); for (int rep = 0; rep < REP_M2; ++rep) { MIXER_PHASE_2; } TP_END(3); SEAM(pb + 2); }
        if (IN(pb + 3)) { TP_BEGIN(4); for (int rep = 0; rep < REP_M3; ++rep) { MIXER_PHASE_3; } TP_END(4); SEAM_L(pb + 3); }
        if (PH_EN_C && IN(pb + 4)) {
            TP_BEGIN(5); OPAQUE_WS();
            pg8::Gemm g{WSP(bf16_t, WS_Y), (const bf16_t*)(wl + WL_C), SEQ, DM, DM}; GEMM_ORDER S; S.init(SEQ, DM, G, cid);
            EpiC E{WSP(unsigned char, WS_GATES), WSP(bf16_t, WS_MERGED)};
            for (int rep = 0; rep < REP_C; ++rep) pg8::gemm_phase<EpiC, GEMM_ORDER>(lds, g, S, E);
            TP_END(5); SEAM_L(pb + 4);
        }
        if (PH_EN_D && IN(pb + 5)) {
            TP_BEGIN(6); OPAQUE_WS();
            pg8::Gemm g{WSP(bf16_t, WS_MERGED), (const bf16_t*)(wl + WL_D), SEQ, DM, DM}; GEMM_ORDER S; S.init(SEQ, DM, G, cid);
#ifdef REP_D
            { EpiD<false> E2{WSP(bf16_t, WS_XB), WSP(float, WS_ML + 28 * MiB), nullptr, WSP(bf16_t, WS_NAIVE + 32 * MiB)}; pg8::gemm_phase<EpiD<false>, GEMM_ORDER>(lds, g, S, E2); }
#endif
            EpiD<false> E{WSP(bf16_t, WS_XB), WSP(float, WS_STATS) + (size_t)SEQ * 32, nullptr, WSP(bf16_t, WS_XB)};
            pg8::gemm_phase<EpiD<false>, GEMM_ORDER>(lds, g, S, E);
            TP_END(6); SEAM_LG(pb + 5, 5u * (unsigned)l_ + 1u);
        }
        if (PH_EN_E && IN(pb + 6)) {
            TP_BEGIN(7); OPAQUE_WS();
            pg8::Gemm g{WSP(bf16_t, WS_XB), (const bf16_t*)(wl + WL_E), SEQ, 2 * FF, DM}; E_ORDER S; S.init(SEQ, 2 * FF, G, cid);
            EpiE E{WSP(float, WS_STATS) + (size_t)SEQ * 32, WSP(bf16_t, WS_H)};
            for (int rep = 0; rep < REP_E; ++rep) pg8::gemm_phase<EpiE, E_ORDER>(lds, g, S, E);
            if (l + 1 < DEPTH && bx >= 128) { int ln = threadIdx.x & 63; asm volatile("" : "+v"(ln)); cvt_tail(args, l + 1, 0, 128 * NWAVES, CV_E_PW, (bx - 128) * NWAVES + wave, lds, wave, ln); }
            TP_END(7); SEAM_L(pb + 6);
        }
        if (PH_EN_F && IN(pb + 7)) {
            TP_BEGIN(8); OPAQUE_WS();
            pg8::Gemm g{WSP(bf16_t, WS_H), (const bf16_t*)(wl + WL_F), SEQ, DM, FF}; GEMM_ORDER S; S.init(SEQ, DM, G, cid);
#ifdef REP_F
            { EpiD<false> E2{WSP(bf16_t, WS_XB), WSP(float, WS_ML + 28 * MiB), nullptr, WSP(bf16_t, WS_NAIVE + 32 * MiB)}; pg8::gemm_phase<EpiD<false>, GEMM_ORDER>(lds, g, S, E2); }
#endif
            if (l + 1 < DEPTH) { EpiD<false> E{WSP(bf16_t, WS_XB), WSP(float, WS_STATS), nullptr, WSP(bf16_t, WS_XB)}; pg8::gemm_phase<EpiD<false>, GEMM_ORDER>(lds, g, S, E); }
            else { EpiD<true> E{WSP(bf16_t, WS_XB), nullptr, args.out, nullptr}; pg8::gemm_phase<EpiD<true>, GEMM_ORDER>(lds, g, S, E); }
            TP_END(8); if (l_ + 1 < DEPTH) SEAM_L(pb + 7);
        }
    }
#ifdef TPROBE
    TP_END(10);
    xcd_barrier(bar);
#if TPROBE == 30
    if (blockIdx.x == 0 && threadIdx.x == 0) { const unsigned long long* st = (const unsigned long long*)(args.ws + WS_CTL + 256 * 1024); unsigned long long lo = ~0ull, hi = 0ull;
        for (int b = 0; b < (int)gridDim.x; ++b) { const unsigned long long v = __hip_atomic_load(st + b, __ATOMIC_RELAXED, __HIP_MEMORY_SCOPE_AGENT); lo = v < lo ? v : lo; hi = v > hi ? v : hi; }
        tp_sum = (unsigned)(hi - lo); }
#endif
    if (blockIdx.x == 0 && threadIdx.x == 0) args.out[0] += ((float)tp_sum * 0.01f - (float)TP_OFF) * 0.01f;
#endif
#undef IN
#undef BOTH
#undef SEAM
#undef SEAM_L
#undef SEAM_LG
}

extern "C" void kernel_launch(void* const* d_in, const int* in_sizes, int n_in, void* d_out, int out_size, void* d_ws, size_t ws_size, hipStream_t stream) {
    static int grid = 0;
    if (grid == 0) {
        if (n_in != N_IN || in_sizes[0] != SEQ * DM || out_size != SEQ * DM || ws_size < WS_END) {
            fprintf(stderr, "kernel_launch: unexpected shapes (n_in %d, in0 %d, out %d, ws %zu < %zu); nothing launched\n", n_in, n_in > 0 ? in_sizes[0] : -1, out_size, ws_size, (size_t)WS_END); grid = -1; return; }
        int dev = 0, cus = 0;
        if (hipGetDevice(&dev) != hipSuccess || hipDeviceGetAttribute(&cus, hipDeviceAttributeMultiprocessorCount, dev) != hipSuccess) { grid = -1; return; }
        if (hipFuncSetAttribute((const void*)mk_fwd, hipFuncAttributeMaxDynamicSharedMemorySize, LDS_BYTES) != hipSuccess) { fprintf(stderr, "kernel_launch: hipFuncSetAttribute failed\n"); grid = -1; return; }
        int per_cu = 0;
        if (hipOccupancyMaxActiveBlocksPerMultiprocessor(&per_cu, (const void*)mk_fwd, NTHREADS, LDS_BYTES) != hipSuccess || per_cu < 1) { fprintf(stderr, "kernel_launch: occupancy query says %d\n", per_cu); }
        (void)hipGetLastError();
        grid = cus;
    }
    if (grid < 0) return;
    (void)hipMemsetAsync((char*)d_ws + WS_CTL, 0, 64 * 1024, stream);
    Args a{};
    for (int i = 0; i < N_IN; ++i) a.in[i] = (const float*)d_in[i];
    a.out = (float*)d_out; a.ws = (unsigned char*)d_ws;
    auto launch = [&](int lo, int hi, int flags = 0) { a.ph_lo = lo; a.ph_hi = hi; a.flags = flags; hipLaunchKernelGGL(mk_fwd, dim3(grid), dim3(NTHREADS), LDS_BYTES, stream, a); };
    unsigned char* ws = (unsigned char*)d_ws;
    const bf16_t* proj = (const bf16_t*)(ws + WS_PROJ); bf16_t* y = (bf16_t*)(ws + WS_Y); const float* ifg = (const float*)(ws + WS_IFG);
    float* XC = (float*)(ws + WS_NAIVE); float* NA_ = (float*)(ws + WS_NAIVE + 16 * MiB); float* NBX = (float*)(ws + WS_NAIVE + 32 * MiB);
    float* QK = (float*)(ws + WS_NAIVE); float* NF = (float*)(ws + WS_NAIVE + 48 * MiB); float* NG_ = (float*)(ws + WS_NAIVE + 49 * MiB);
    launch(0, N_PHASES, 15);
}
```

```cpp
#include <hip/hip_runtime.h>
#include <cstdio>
#include <cstdint>

#define LAS __attribute__((address_space(3)))
#define GAS __attribute__((address_space(1)))
typedef unsigned short bf16_t;
typedef short bf16x8 __attribute__((ext_vector_type(8)));
typedef short s16x4 __attribute__((ext_vector_type(4)));
typedef float f32x4 __attribute__((ext_vector_type(4)));
typedef float f32x2 __attribute__((ext_vector_type(2)));
typedef unsigned u32x4 __attribute__((ext_vector_type(4)));
typedef unsigned u32x2 __attribute__((ext_vector_type(2)));

constexpr int SEQ = 8192, DM = 2048, DEPTH = 4, BW = 512, GD = 128, NG = 4, FF = 5632, INW = 5640;
constexpr int NA = 14080;
constexpr int PROJ_LD = 5632;
constexpr int GATES_LD = 8192;
constexpr float EPS = 1e-6f;
constexpr int NWAVES = 8, NTHREADS = 512;
constexpr int LDS_BYTES = 160 * 1024;
constexpr int LDS_MISC = LDS_BYTES - 64;

enum { I_X = 0, I_NORM_MIX, I_W_IN, I_GM_NORM_V, I_GM_W_S, I_GM_B_S, I_LRU_CONV_W, I_LRU_CONV_B, I_LRU_W_R, I_LRU_B_R, I_LRU_W_I, I_LRU_B_I, I_LRU_LAMBDA,
       I_ML_CONV_W, I_ML_CONV_B, I_ML_B_I, I_ML_B_F, I_ML_NORM_H, I_SB_NORM_Q, I_SB_NORM_K, I_W_BRANCH, I_W_GATE, I_B_GATE, I_W_OUT, I_NORM_FFN,
       I_W_FFN_GATE, I_W_FFN_UP, I_W_FFN_DOWN, N_IN };

constexpr size_t MiB = 1u << 20;
constexpr size_t WS_CTL = 0;
constexpr size_t WS_STATS = 1 * MiB;
constexpr size_t WS_IFG = 3 * MiB;
constexpr size_t WS_LRU_AH = 3 * MiB + 512 * 1024;
constexpr size_t WS_GVS = 3 * MiB + 768 * 1024;
constexpr size_t WS_SMALLW = 4 * MiB;
constexpr size_t WS_XB = 8 * MiB;
constexpr size_t WS_Y = 40 * MiB;
constexpr size_t WS_MERGED = 72 * MiB;
constexpr size_t WS_PROJ = 104 * MiB;
constexpr size_t WS_GATES = 192 * MiB;
constexpr size_t WS_H = WS_PROJ;
constexpr size_t WS_ML = 320 * MiB;
constexpr size_t WS_NAIVE = 352 * MiB;
constexpr size_t WS_W = 416 * MiB;
constexpr size_t WL_A = 0, WL_C = 55 * MiB, WL_D = 63 * MiB, WL_E = 71 * MiB, WL_F = 115 * MiB, WL_STRIDE = 137 * MiB;
constexpr size_t WS_END = WS_W + DEPTH * WL_STRIDE;

typedef __bf16 bf16x2_t __attribute__((ext_vector_type(2)));
__device__ __forceinline__ unsigned cvt_pk_bf16(float lo, float hi) { const f32x2 v = {lo, hi}; return __builtin_bit_cast(unsigned, __builtin_convertvector(v, bf16x2_t)); }
__device__ __forceinline__ bf16_t f2bf(float f) { unsigned u = __builtin_bit_cast(unsigned, f); return (bf16_t)((u + 0x7fffu + ((u >> 16) & 1u)) >> 16); }
__device__ __forceinline__ float bf2f(bf16_t b) { return __builtin_bit_cast(float, (unsigned)b << 16); }
__device__ __forceinline__ float bflo(unsigned w) { return __builtin_bit_cast(float, w << 16); }
__device__ __forceinline__ float bfhi(unsigned w) { return __builtin_bit_cast(float, w & 0xffff0000u); }
__device__ __forceinline__ float sigmoidf_(float x) { return __builtin_amdgcn_rcpf(1.0f + __builtin_amdgcn_exp2f(-1.4426950408889634f * x)); }
__device__ __forceinline__ float gelu_tanh(float x) { const float u = 0.7978845608028654f * (x + 0.044715f * x * x * x); return x * sigmoidf_(2.0f * u); }
__device__ __forceinline__ float softplusf_(float x) { return fmaxf(x, 0.f) + log1pf(__expf(-fabsf(x))); }
__device__ __forceinline__ float logsigf_(float x) { return -softplusf_(-x); }
__device__ __forceinline__ float wave_sum(float v) {
#pragma unroll
    for (int o = 1; o < 64; o <<= 1) v += __shfl_xor(v, o);
    return v;
}
#define LDS_WAIT() asm volatile("s_waitcnt lgkmcnt(0)" ::: "memory")
#define VM_WAIT() asm volatile("s_waitcnt vmcnt(0)" ::: "memory")
namespace pg8 {
#define PG8_LAS __attribute__((address_space(3)))
constexpr int BM = 256, BK = 64, HALF = 128, HTB = HALF * BK * 2  , STAGE_BYTES = 8 * HTB, NXCD = 8, WGM = 8;

__host__ __device__ __forceinline__ int lds_byte(int r, int c) { const int st = (r >> 4) * 2 + (c >> 5), rr = r & 15, cc = c & 31, ob = rr * 64 + cc * 2; return st * 1024 + (ob ^ (((ob >> 9) & 1) << 5)); }
__host__ __device__ __forceinline__ void stage_rc(int b, int& R, int& C) { const int st = b / 1024, sb = b % 1024, swz = sb ^ (((sb >> 9) & 1) << 5); R = (st >> 1) * 16 + swz / 64; C = (st & 1) * 32 + (swz % 64) / 2; }
__host__ __device__ __forceinline__ int perm32(int rho) { const int n = rho >> 4, i = rho & 15; return 8 * (i >> 2) + 4 * n + (i & 3); }

struct Unit { int pm, pn; };
struct Gemm { const bf16_t* A; const bf16_t* Bt; int M, N, K; };

struct StaticOrder {
    int nM, nN, nwg, G, c;
    __host__ __device__ void init(int M, int N, int G_, int c_) { nM = M / BM; nN = N / BM; nwg = nM * nN; G = G_; c = c_; }
    __host__ __device__ bool next(int i, Unit& u) const {
        const long L = (long)i * G + c; if (L >= nwg) return false;
        int wgid = (int)L; { const int q = nwg / NXCD, r = nwg % NXCD, xcd = wgid % NXCD, off = wgid / NXCD; wgid = (xcd < r ? xcd * (q + 1) : r * (q + 1) + (xcd - r) * q) + off; }
        const int nig = WGM * nN, gid = wgid / nig, fm = gid * WGM, gsz = (nM - fm) < WGM ? (nM - fm) : WGM;
        u.pm = fm + ((wgid % nig) % gsz); u.pn = (wgid % nig) / gsz; return true;
    }
};

struct PanelOrder {
    int nM, nN, nwg, G, c;
    __host__ __device__ void init(int M, int N, int G_, int c_) { nM = M / BM; nN = N / BM; nwg = nM * nN; G = G_; c = c_; }
    __host__ __device__ bool next(int i, Unit& u) const {
        if (G != 256 || nM != 32) { const long L = (long)i * G + c; if (L >= nwg) return false; u.pm = (int)(L % nM); u.pn = (int)(L / nM); return true; }
        const int x = c & 7, j = c >> 3, q = i * 32 + j;
        if (q >= 4 * nN) return false;
        u.pm = 4 * x + (q & 3); u.pn = q >> 2; return true;
    }
};
template <class Epi, class Sched>
__device__ __forceinline__ void gemm_phase(PG8_LAS unsigned char* lds, const Gemm g, const Sched& S, const Epi& E) {
    int tid_ = threadIdx.x; asm volatile("" : "+v"(tid_));
    const int tid = tid_, wid = __builtin_amdgcn_readfirstlane(tid >> 6), lane = tid & 63, wr = wid >> 2, wc = wid & 3, fr = lane & 15, fq = lane >> 4;
    const int K = g.K, nt = K / BK;
    unsigned voffA[2], voffB[2];
#pragma unroll
    for (int i = 0; i < 2; ++i) { int R, C; stage_rc(tid * 16 + i * 8192, R, C); const int Rb = Epi::PERM ? ((R & ~31) + perm32(R & 31)) : R;
        voffA[i] = (unsigned)(R * K + C) * 2u; voffB[i] = (unsigned)(Rb * K + C) * 2u; }
    const size_t kstep = (size_t)(BK * 2);
    const size_t hstep = (size_t)HALF * K * 2;
    const size_t tstep = 2 * hstep;
    const unsigned ldsw = (unsigned)wid * 1024u;
    const int aoff = lds_byte(wr * 64 + fr, fq * 8), boff = lds_byte(wc * 32 + fr, fq * 8);
#define PG8_SA(b, h) (((b) * 2 + (h)) * HTB)
#define PG8_SB(b, h) ((4 + (b) * 2 + (h)) * HTB)
#define PG8_STAGE(bufoff, gbase, voff) do { _Pragma("unroll") for (int _i = 0; _i < 2; ++_i) \
        __builtin_amdgcn_global_load_lds((const unsigned*)((const char*)(gbase) + (voff)[_i]), (PG8_LAS unsigned*)(lds + (bufoff) + ldsw + _i * 8192), 16, 0, 0); } while (0)
#define PG8_LDA(dst, b, h) do { _Pragma("unroll") for (int m = 0; m < 4; ++m) _Pragma("unroll") for (int k = 0; k < 2; ++k) dst[m][k] = *(const PG8_LAS bf16x8*)(lds + PG8_SA(b, h) + aoff + m * 2048 + k * 1024); } while (0)
#define PG8_LDB(dst, b, h) do { _Pragma("unroll") for (int n = 0; n < 2; ++n) _Pragma("unroll") for (int k = 0; k < 2; ++k) dst[n][k] = *(const PG8_LAS bf16x8*)(lds + PG8_SB(b, h) + boff + n * 2048 + k * 1024); } while (0)
#define PG8_MMA(ai, bj, At, Bt) do { __builtin_amdgcn_s_setprio(1); _Pragma("unroll") for (int m = 0; m < 4; ++m) _Pragma("unroll") for (int n = 0; n < 2; ++n) _Pragma("unroll") for (int k = 0; k < 2; ++k) \
        acc[ai][bj][m][n] = __builtin_amdgcn_mfma_f32_16x16x32_bf16(Bt[n][k], At[m][k], acc[ai][bj][m][n], 0, 0, 0); __builtin_amdgcn_s_setprio(0); } while (0)
#define PG8_WAIT_V(n) asm volatile("s_waitcnt vmcnt(" #n ")" ::: "memory")
#define PG8_WAIT_L(n) asm volatile("s_waitcnt lgkmcnt(" #n ")" ::: "memory")
#define PG8_BAR __builtin_amdgcn_s_barrier()
#define PG8_SCHED __builtin_amdgcn_sched_barrier(0)
    Unit cur, nxt; int ui = 0;
    if (!S.next(0, cur)) return;
    f32x4 acc[2][2][4][2];
#pragma unroll
    for (int a = 0; a < 2; ++a)
#pragma unroll
        for (int b = 0; b < 2; ++b)
#pragma unroll
            for (int m = 0; m < 4; ++m)
#pragma unroll
                for (int n = 0; n < 2; ++n) acc[a][b][m][n] = (f32x4){0.f, 0.f, 0.f, 0.f};
    bf16x8 At[4][2], B0[2][2], B1[2][2];
    const char* cA = (const char*)g.A + (size_t)cur.pm * tstep; const char* cB = (const char*)g.Bt + (size_t)cur.pn * tstep;
    int cached_pm = -1;
    E.next(cur, 0, lds, wid, lane);
    PG8_STAGE(PG8_SB(0, 0), cB, voffB); PG8_STAGE(PG8_SB(0, 1), cB + hstep, voffB); PG8_STAGE(PG8_SA(0, 0), cA, voffA); PG8_STAGE(PG8_SA(0, 1), cA + hstep, voffA);
    if (wr == 1) PG8_BAR;
    PG8_WAIT_V(2); PG8_BAR;
    PG8_STAGE(PG8_SB(1, 0), cB + kstep, voffB); PG8_STAGE(PG8_SA(1, 0), cA + kstep, voffA); PG8_STAGE(PG8_SB(1, 1), cB + hstep + kstep, voffB);
    PG8_WAIT_V(6); PG8_BAR;
    for (;;) {
        const bool has_next = S.next(ui + 1, nxt);
        const char* nA = has_next ? (const char*)g.A + (size_t)nxt.pm * tstep : cA; const char* nB = has_next ? (const char*)g.Bt + (size_t)nxt.pn * tstep : cB;
        for (int t = 0; t < nt; t += 2) {
            const bool last = (t == nt - 2);
            const char* a1 = cA + (size_t)(t + 1) * kstep;
            const char* a2 = last ? nA : cA + (size_t)(t + 2) * kstep; const char* b2 = last ? nB : cB + (size_t)(t + 2) * kstep;
            const char* a3 = a2 + kstep; const char* b3 = b2 + kstep;
            PG8_LDB(B0, 0, 0); PG8_LDB(B1, 0, 1); PG8_SCHED; PG8_LDA(At, 0, 0); PG8_STAGE(PG8_SA(1, 1), a1 + hstep, voffA);
            PG8_WAIT_V(8); PG8_WAIT_L(0); PG8_BAR; PG8_MMA(0, 0, At, B0); PG8_MMA(0, 1, At, B1); PG8_BAR; PG8_SCHED;
            PG8_LDA(At, 0, 1); PG8_STAGE(PG8_SB(0, 0), b2, voffB); PG8_STAGE(PG8_SB(0, 1), b2 + hstep, voffB); PG8_STAGE(PG8_SA(0, 0), a2, voffA);
            PG8_WAIT_V(8); PG8_WAIT_L(0); PG8_BAR; PG8_MMA(1, 0, At, B0); PG8_MMA(1, 1, At, B1); PG8_BAR; PG8_SCHED;
            PG8_LDB(B0, 1, 0); PG8_LDB(B1, 1, 1); PG8_SCHED; PG8_LDA(At, 1, 0); PG8_STAGE(PG8_SA(0, 1), a2 + hstep, voffA);
            PG8_WAIT_V(8); PG8_WAIT_L(0); PG8_BAR; PG8_MMA(0, 0, At, B0); PG8_MMA(0, 1, At, B1); PG8_BAR; PG8_SCHED;
            PG8_LDA(At, 1, 1); PG8_STAGE(PG8_SB(1, 0), b3, voffB); PG8_STAGE(PG8_SB(1, 1), b3 + hstep, voffB); PG8_STAGE(PG8_SA(1, 0), a3, voffA);
            PG8_WAIT_V(8); PG8_WAIT_L(0); PG8_BAR; PG8_MMA(1, 0, At, B0); PG8_MMA(1, 1, At, B1); PG8_BAR; PG8_SCHED;
            if constexpr (Epi::FOLD) { if (!last && ((t + 2) & 7) == 0) {
                if (wr == 0) PG8_BAR; E.fold(acc, cur, ((t + 2) >> 3) - 1, wr, wc, fr, fq); PG8_SCHED; if (wr == 1) PG8_BAR; } }
        }
        if (wr == 0) PG8_BAR;
        E.prep(cur, cached_pm, lds, wid, lane);
        E(acc, cur, ui, lds, wid, wr, wc, fr, fq);
        if (has_next) E.next(nxt, ui + 1, lds, wid, lane);
#ifdef REP_EPI
        if constexpr (Epi::REPEAT == REP_EPI) { PG8_SCHED; E(acc, cur, ui, lds, wid, wr, wc, fr, fq); }
#endif
        if (!has_next) break;
#pragma unroll
        for (int a = 0; a < 2; ++a)
#pragma unroll
            for (int b = 0; b < 2; ++b)
#pragma unroll
                for (int m = 0; m < 4; ++m)
#pragma unroll
                    for (int n = 0; n < 2; ++n) acc[a][b][m][n] = (f32x4){0.f, 0.f, 0.f, 0.f};
        cur = nxt; cA = nA; cB = nB; ++ui;
        if (wr == 1) PG8_BAR;
    }
    PG8_WAIT_V(0);
    PG8_BAR;
#undef PG8_SA
#undef PG8_SB
#undef PG8_STAGE
#undef PG8_LDA
#undef PG8_LDB
#undef PG8_MMA
#undef PG8_WAIT_V
#undef PG8_WAIT_L
#undef PG8_BAR
#undef PG8_SCHED
}
}
#define XB_TMO      128
#define XB_XCNT(j)  (256  + 64 * (j))
#define XB_XSUB(j)  (1280 + 64 * (j))
#define XB_XGEN(j)  (2304 + 64 * (j))
#define XB_TOP      3328
#define XB_TOPGEN   3392
#define XCD_BAR_WORDS 3456
#define XB_SPIN_CAP (1u << 18)

__device__ __forceinline__ unsigned xb_ld(unsigned* p)              { return __hip_atomic_load(p, __ATOMIC_RELAXED, __HIP_MEMORY_SCOPE_AGENT); }
__device__ __forceinline__ unsigned xb_add(unsigned* p, unsigned v) { return __hip_atomic_fetch_add(p, v, __ATOMIC_RELAXED, __HIP_MEMORY_SCOPE_AGENT); }
__device__ __forceinline__ unsigned xb_xcc_id() { return (unsigned)__builtin_amdgcn_s_getreg((3 << 11) | 20) & 0xFu; }
#define XB_SPIN(cond, bar) do { unsigned _sp = 0; while (cond) { __builtin_amdgcn_s_sleep(1); \
    if ((++_sp & 255u) == 0u) { if (xb_ld(&(bar)[XB_TMO])) break; if (_sp > XB_SPIN_CAP) { atomicAdd(&(bar)[XB_TMO], 1u); break; } } } } while (0)

struct XcdBarrier {
    unsigned* bar; unsigned x;
    volatile LAS unsigned* st;
};

__device__ __forceinline__ XcdBarrier xcd_barrier_post(unsigned* bar, volatile LAS unsigned* st) {
    XcdBarrier b; b.bar = bar; b.x = xb_xcc_id(); b.st = st;
    if (threadIdx.x == 0) (void)xb_add(&bar[XB_XCNT(b.x)], 1u);
    return b;
}
__device__ __forceinline__ void xcd_barrier_complete(unsigned* bar, unsigned x, unsigned& nloc, unsigned& nx) {
    const unsigned G = gridDim.x * gridDim.y * gridDim.z;
    unsigned sum, cnt, mine, sp = 0u;
    for (;;) {
        sum = 0u; cnt = 0u; mine = 0u;
#pragma unroll
        for (unsigned j = 0; j < 16; ++j) { const unsigned c = xb_ld(&bar[XB_XCNT(j)]); sum += c; cnt += (c > 0u) ? 1u : 0u; mine = (j == x) ? c : mine; }
        if (sum == G) break;
        __builtin_amdgcn_s_sleep(1);
        if ((++sp & 255u) == 0u) { if (xb_ld(&bar[XB_TMO])) break; if (sp > XB_SPIN_CAP) { atomicAdd(&bar[XB_TMO], 1u); break; } }
    }
    nloc = mine > 0u ? mine : 1u; nx = cnt > 0u ? cnt : 1u;
}

__device__ __forceinline__ void xcd_barrier(const XcdBarrier& b) {
    asm volatile("s_waitcnt vmcnt(0)" ::: "memory");
    __syncthreads();
    if (threadIdx.x == 0) {
        unsigned* bar = b.bar;
        __builtin_amdgcn_s_waitcnt(0);
        unsigned nloc = b.st[0], nx = b.st[1];
        if (nloc == 0u) { xcd_barrier_complete(bar, b.x, nloc, nx); b.st[0] = nloc; b.st[1] = nx; }
        const unsigned old = xb_add(&bar[XB_XSUB(b.x)], 1u);
        const unsigned gen = old / nloc;
        if (old + 1u == (gen + 1u) * nloc) {
            __builtin_amdgcn_fence(__ATOMIC_RELEASE, "agent");
            asm volatile("s_waitcnt vmcnt(0)" ::: "memory");
            const unsigned og = xb_add(&bar[XB_TOP], 1u);
            const unsigned tg = og / nx;
            if (og + 1u == (tg + 1u) * nx) xb_add(&bar[XB_TOPGEN], 1u);
            else XB_SPIN(xb_ld(&bar[XB_TOPGEN]) == tg, bar);
            __builtin_amdgcn_fence(__ATOMIC_ACQUIRE, "agent");
            xb_add(&bar[XB_XGEN(b.x)], 1u);
            asm volatile("s_waitcnt vmcnt(0)" ::: "memory");
        } else {
            XB_SPIN(xb_ld(&bar[XB_XGEN(b.x)]) == gen, bar);
            __builtin_amdgcn_fence(__ATOMIC_ACQUIRE, "agent");
            asm volatile("s_waitcnt vmcnt(0)" ::: "memory");
        }
    }
    __syncthreads();
}
constexpr int EPI_RSTD = 131072, EPI_BIAS = 131072 + 4096;
__device__ __forceinline__ void rstd_prep(const float* stats, const pg8::Unit& u, int& cached_pm, LAS unsigned char* lds, int wid, int lane) {
    if (u.pm == cached_pm) return;
    cached_pm = u.pm;
    LAS float* tab = (LAS float*)(lds + EPI_RSTD + wid * 512); const int wr = wid >> 2;
#pragma unroll
    for (int q = 0; q < 2; ++q) { const int j = lane + 64 * q, row = u.pm * 256 + (j >> 6) * 128 + wr * 64 + (j & 63);
        const f32x4* p = (const f32x4*)(stats + (size_t)row * 32); f32x4 s = p[0];
#pragma unroll
        for (int i = 1; i < 8; ++i) s = s + p[i];
        tab[j] = rsqrtf(((s.x + s.y) + (s.z + s.w)) * (1.0f / (float)DM) + EPS); }
    LDS_WAIT();
}
__device__ __forceinline__ void load_rstd(LAS unsigned char* lds, int wid, int fr, float (&rs)[2][4]) {
    const LAS float* tab = (const LAS float*)(lds + EPI_RSTD + wid * 512);
#pragma unroll
    for (int ai = 0; ai < 2; ++ai)
#pragma unroll
        for (int m = 0; m < 4; ++m) rs[ai][m] = tab[ai * 64 + m * 16 + fr];
}
__device__ __forceinline__ u32x4 pack8(const f32x4 v0, const f32x4 v1) { u32x4 w; w.x = cvt_pk_bf16(v0[0], v0[1]); w.y = cvt_pk_bf16(v0[2], v0[3]); w.z = cvt_pk_bf16(v1[0], v1[1]); w.w = cvt_pk_bf16(v1[2], v1[3]); return w; }

struct EpiA {
    static constexpr bool PERM = true, FOLD = false; static constexpr int REPEAT = 1;
    const float* stats; bf16_t* proj; float* ifg; unsigned char* gates; const float* bgate; float* gvs;
    __device__ __forceinline__ void prep(const pg8::Unit& u, int& cached_pm, LAS unsigned char* lds, int wid, int lane) const { rstd_prep(stats, u, cached_pm, lds, wid, lane); }
    __device__ __forceinline__ void next(const pg8::Unit& u, int ui, LAS unsigned char* lds, int wid, int lane) const {
        if (u.pn >= 23 && wid < 4) { const int gi = u.pn - 23;
            __builtin_amdgcn_global_load_lds((const unsigned*)(bgate + (gi >> 3) * 2048 + (gi & 7) * 256 + wid * 64 + lane), (LAS unsigned*)(lds + EPI_BIAS + (ui & 1) * 1024 + wid * 256), 4, 0, 0); }
    }
    __device__ __forceinline__ void operator()(const f32x4 (&acc)[2][2][4][2], const pg8::Unit& u, int ui, LAS unsigned char* lds, int wid, int wr, int wc, int fr_, int fq_) const {
        int fr = fr_, fq = fq_; asm volatile("" : "+v"(fr), "+v"(fq));
        float rs[2][4]; load_rstd(lds, wid, fr, rs);
        const int row0 = u.pm * 256 + wr * 64 + fr;
        if (u.pn < 22) {
            const int col0 = u.pn * 256 + wc * 32 + 8 * fq;
#pragma unroll
            for (int ai = 0; ai < 2; ++ai)
#pragma unroll
                for (int m = 0; m < 4; ++m) { bf16_t* rowp = proj + (size_t)(row0 + ai * 128 + m * 16) * PROJ_LD + col0; const float r = rs[ai][m];
#pragma unroll
                    for (int bj = 0; bj < 2; ++bj) *(u32x4*)(rowp + bj * 128) = pack8(acc[ai][bj][m][0] * r, acc[ai][bj][m][1] * r);
                    if (u.pn == 2 || u.pn == 3) {
                        float ss = 0.f;
#pragma unroll
                        for (int bj = 0; bj < 2; ++bj)
#pragma unroll
                            for (int n = 0; n < 2; ++n)
#pragma unroll
                                for (int j = 0; j < 4; ++j) { const float gv = gelu_tanh(acc[ai][bj][m][n][j] * r); ss += gv * gv; }
                        ss += __shfl_xor(ss, 16); ss += __shfl_xor(ss, 32);
                        if (fq == 0) gvs[(size_t)(row0 + ai * 128 + m * 16) * 8 + (u.pn - 2) * 4 + wc] = ss; } }
        } else if (u.pn == 22) {
            if (wc == 0 && fq == 0) {
#pragma unroll
                for (int ai = 0; ai < 2; ++ai)
#pragma unroll
                    for (int m = 0; m < 4; ++m) { float* p = ifg + (size_t)(row0 + ai * 128 + m * 16) * 8; const float r = rs[ai][m];
                        *(f32x4*)p = acc[ai][0][m][0] * r; *(f32x4*)(p + 4) = acc[ai][0][m][1] * r; }
            }
        } else {
            const int gi = u.pn - 23;
            const LAS float* bl = (const LAS float*)(lds + EPI_BIAS + (ui & 1) * 1024) + wc * 32 + 8 * fq;
            f32x4 bv[2][2];
#pragma unroll
            for (int bj = 0; bj < 2; ++bj)
#pragma unroll
                for (int n = 0; n < 2; ++n) bv[bj][n] = *(const LAS f32x4*)(bl + 128 * bj + 4 * n) * -1.4426950408889634f;
            unsigned char* gp = gates + ((size_t)((u.pm * 8 + (gi & 7)) * 4 + (gi >> 3)) << 16) + wid * 8192 + (fq * 16 + fr) * 16;
#pragma unroll
            for (int ai = 0; ai < 2; ++ai)
#pragma unroll
                for (int m = 0; m < 4; ++m) { const float r = rs[ai][m] * -1.4426950408889634f; u32x4 qw;
#pragma unroll
                    for (int bj = 0; bj < 2; ++bj)
#pragma unroll
                        for (int n = 0; n < 2; ++n) { const f32x4 t = acc[ai][bj][m][n] * r + bv[bj][n]; unsigned w = 0u;
#define SG256(x) (__builtin_amdgcn_rcpf(1.0f + __builtin_amdgcn_exp2f(x)) * 256.0f - 0.5f)
                            w = __builtin_amdgcn_cvt_pk_u8_f32(SG256(t[0]), 0, w); w = __builtin_amdgcn_cvt_pk_u8_f32(SG256(t[1]), 1, w);
                            w = __builtin_amdgcn_cvt_pk_u8_f32(SG256(t[2]), 2, w); w = __builtin_amdgcn_cvt_pk_u8_f32(SG256(t[3]), 3, w);
#undef SG256
                            qw[2 * bj + n] = w; }
                    *(u32x4*)(gp + (ai * 4 + m) * 1024) = qw; }
        }
    }
};
struct EpiC {
    static constexpr bool PERM = true, FOLD = true; static constexpr int REPEAT = 0;
    const unsigned char* gates; bf16_t* merged;
    __device__ __forceinline__ void prep(const pg8::Unit&, int&, LAS unsigned char*, int, int) const {}
    __device__ __forceinline__ void next(const pg8::Unit&, int, LAS unsigned char*, int, int) const {}
    static __device__ __forceinline__ void unq(const u32x2 w, float (&x)[8]) {
        x[0] = (float)(w.x & 0xffu) + 0.5f; x[1] = (float)((w.x >> 8) & 0xffu) + 0.5f; x[2] = (float)((w.x >> 16) & 0xffu) + 0.5f; x[3] = (float)(w.x >> 24) + 0.5f;
        x[4] = (float)(w.y & 0xffu) + 0.5f; x[5] = (float)((w.y >> 8) & 0xffu) + 0.5f; x[6] = (float)((w.y >> 16) & 0xffu) + 0.5f; x[7] = (float)(w.y >> 24) + 0.5f; }
    __device__ __forceinline__ void fold(f32x4 (&acc)[2][2][4][2], const pg8::Unit& u, int g, int wr, int wc, int fr_, int fq_) const {
        int fr = fr_, fq = fq_; asm volatile("" : "+v"(fr), "+v"(fq));
        const unsigned off0 = ((unsigned)((u.pm * 8 + u.pn) * 4 + g) << 16) + (unsigned)((wr * 4 + wc) * 8192 + (fq * 16 + fr) * 16);
        const unsigned char* gb = gates;
#pragma unroll
        for (int ai = 0; ai < 2; ++ai) {
#pragma unroll
            for (int m = 0; m < 4; ++m) { const unsigned off = off0 + (unsigned)((ai * 4 + m) * 1024);
                const u32x4 wa = *(const u32x4*)(gb + off), wb = *(const u32x4*)(gb + off + 65536u);
#pragma unroll
                for (int bj = 0; bj < 2; ++bj) { float a[8], b[8]; unq((u32x2){wa[2 * bj], wa[2 * bj + 1]}, a); unq((u32x2){wb[2 * bj], wb[2 * bj + 1]}, b);
#pragma unroll
                    for (int q = 0; q < 8; q += 2) { const float rp = __builtin_amdgcn_rcpf(b[q] * b[q + 1]);
                        acc[ai][bj][m][q >> 2][q & 3] *= (a[q] * b[q + 1]) * rp; acc[ai][bj][m][q >> 2][(q & 3) + 1] *= (a[q + 1] * b[q]) * rp; } } } }
    }
    __device__ __forceinline__ void operator()(const f32x4 (&acc)[2][2][4][2], const pg8::Unit& u, int, LAS unsigned char*, int wid, int wr, int wc, int fr_, int fq_) const {
        int fr = fr_, fq = fq_; asm volatile("" : "+v"(fr), "+v"(fq));
        const int row0 = u.pm * 256 + wr * 64 + fr, col0 = u.pn * 256 + wc * 32 + 8 * fq;
        const unsigned goff0 = ((unsigned)((u.pm * 8 + u.pn) * 4 + 3) << 16) + (unsigned)(wid * 8192 + (fq * 16 + fr) * 16), moff0 = (unsigned)row0 * (DM * 2u) + (unsigned)col0 * 2u;
        const unsigned char* gb = gates; char* mb = (char*)merged;
#pragma unroll
        for (int ai = 0; ai < 2; ++ai)
#pragma unroll
            for (int m = 0; m < 4; ++m) { const unsigned moff = moff0 + (unsigned)(ai * 128 + m * 16) * (DM * 2u);
                const u32x4 wa = *(const u32x4*)(gb + goff0 + (unsigned)((ai * 4 + m) * 1024));
#pragma unroll
                for (int bj = 0; bj < 2; ++bj) { float a[8]; unq((u32x2){wa[2 * bj], wa[2 * bj + 1]}, a); f32x4 v0 = acc[ai][bj][m][0], v1 = acc[ai][bj][m][1];
#pragma unroll
                    for (int q = 0; q < 4; ++q) { v0[q] *= a[q] * (1.0f / 256.0f); v1[q] *= a[4 + q] * (1.0f / 256.0f); }
                    *(u32x4*)(mb + moff + bj * 256) = pack8(v0, v1); } }
    }
};
template <bool LAST> struct EpiD {
    static constexpr bool PERM = true, FOLD = false; static constexpr int REPEAT = 0;
    bf16_t* xb; float* stats_out; float* out; bf16_t* xdst;
    __device__ __forceinline__ void prep(const pg8::Unit&, int&, LAS unsigned char*, int, int) const {}
    __device__ __forceinline__ void next(const pg8::Unit&, int, LAS unsigned char*, int, int) const {}
    __device__ __forceinline__ void operator()(const f32x4 (&acc)[2][2][4][2], const pg8::Unit& u, int, LAS unsigned char*, int, int wr, int wc, int fr_, int fq) const {
        int fr = fr_; asm volatile("" : "+v"(fr));
        const int row0 = u.pm * 256 + wr * 64 + fr, col0 = u.pn * 256 + wc * 32 + 8 * fq;
#pragma unroll
        for (int ai = 0; ai < 2; ++ai) {
            u32x4 xo[4][2];
#pragma unroll
            for (int m = 0; m < 4; ++m)
#pragma unroll
                for (int bj = 0; bj < 2; ++bj) xo[m][bj] = *(const u32x4*)(xb + (size_t)(row0 + ai * 128 + m * 16) * DM + col0 + bj * 128);
#pragma unroll
            for (int m = 0; m < 4; ++m) { const int row = row0 + ai * 128 + m * 16; const size_t off = (size_t)row * DM + col0; float ss = 0.f;
#pragma unroll
                for (int bj = 0; bj < 2; ++bj) { const u32x4 xw = xo[m][bj];
                    f32x4 v0 = acc[ai][bj][m][0], v1 = acc[ai][bj][m][1];
                    v0[0] += bflo(xw.x); v0[1] += bfhi(xw.x); v0[2] += bflo(xw.y); v0[3] += bfhi(xw.y); v1[0] += bflo(xw.z); v1[1] += bfhi(xw.z); v1[2] += bflo(xw.w); v1[3] += bfhi(xw.w);
                    if (LAST) { *(f32x4*)(out + off + bj * 128) = v0; *(f32x4*)(out + off + bj * 128 + 4) = v1; }
                    else { const u32x4 pw = pack8(v0, v1); *(u32x4*)(xdst + off + bj * 128) = pw;
                        const float r0 = bflo(pw.x), r1 = bfhi(pw.x), r2 = bflo(pw.y), r3 = bfhi(pw.y), r4 = bflo(pw.z), r5 = bfhi(pw.z), r6 = bflo(pw.w), r7 = bfhi(pw.w);
                        ss += ((r0 * r0 + r1 * r1) + (r2 * r2 + r3 * r3)) + ((r4 * r4 + r5 * r5) + (r6 * r6 + r7 * r7)); } }
                if (!LAST) { ss += __shfl_xor(ss, 16); ss += __shfl_xor(ss, 32);
                    if (fq == 0) stats_out[(size_t)row * 32 + u.pn * 4 + wc] = ss; } }
            asm volatile("" ::: "memory"); }
    }
};
struct EpiE {
    static constexpr bool PERM = true, FOLD = false; static constexpr int REPEAT = 2;
    const float* stats; bf16_t* h;
    __device__ __forceinline__ void prep(const pg8::Unit& u, int& cached_pm, LAS unsigned char* lds, int wid, int lane) const { rstd_prep(stats, u, cached_pm, lds, wid, lane); }
    __device__ __forceinline__ void next(const pg8::Unit&, int, LAS unsigned char*, int, int) const {}
    __device__ __forceinline__ void operator()(const f32x4 (&acc)[2][2][4][2], const pg8::Unit& u, int, LAS unsigned char* lds, int wid, int wr, int wc, int fr_, int fq_) const {
        int fr = fr_, fq = fq_; asm volatile("" : "+v"(fr), "+v"(fq));
        float rs[2][4]; load_rstd(lds, wid, fr, rs);
        const int row0 = u.pm * 256 + wr * 64 + fr, col0 = u.pn * 128 + wc * 32 + 8 * fq;
#pragma unroll
        for (int ai = 0; ai < 2; ++ai)
#pragma unroll
            for (int m = 0; m < 4; ++m) { const float r = rs[ai][m], r2 = r * r, rl = r * -1.4426950408889634f; f32x4 o[2];
#pragma unroll
                for (int n = 0; n < 2; ++n) { const f32x4 ga = acc[ai][0][m][n], ua = acc[ai][1][m][n]; const f32x4 p = ga * ua * r2, t = ga * rl;
#pragma unroll
                    for (int j = 0; j < 4; ++j) o[n][j] = p[j] * __builtin_amdgcn_rcpf(1.0f + __builtin_amdgcn_exp2f(t[j])); }
                *(u32x4*)(h + (size_t)(row0 + ai * 128 + m * 16) * FF + col0) = pack8(o[0], o[1]); }
    }
};
__device__ __forceinline__ void cvt_item(const float* W, int ldw, int k0, int c0, bf16_t* WT, size_t dld, int drow0, int dcol0, const float* gain, int nvalid, LAS float* scr, int lane, bool gateperm = false) {
    const int c4 = lane & 15, r4 = lane >> 4;
    f32x4 v[16];
#pragma unroll
    for (int i = 0; i < 16; ++i) v[i] = __builtin_nontemporal_load((const GAS f32x4*)(W + (size_t)(k0 + 4 * i + r4) * ldw + c0 + 4 * c4));
    if (gain) {
#pragma unroll
        for (int i = 0; i < 16; ++i) v[i] = v[i] * gain[k0 + 4 * i + r4];
    }
#pragma unroll
    for (int i = 0; i < 16; ++i)
#pragma unroll
        for (int j = 0; j < 4; ++j) scr[(4 * c4 + j) * 65 + 4 * i + r4] = v[i][j];
    LDS_WAIT();
    const int c = lane & 7, ns = lane >> 3;
#pragma unroll
    for (int p = 0; p < 8; ++p) { const int n = 8 * p + ns; const LAS float* s = scr + n * 65 + 8 * c;
        u32x4 o; o.x = cvt_pk_bf16(s[0], s[1]); o.y = cvt_pk_bf16(s[2], s[3]); o.z = cvt_pk_bf16(s[4], s[5]); o.w = cvt_pk_bf16(s[6], s[7]);
        if (n >= nvalid) o = (u32x4){0u, 0u, 0u, 0u};
        const int nr = gateperm ? 128 * ((n >> 3) & 1) + 8 * (n >> 4) + (n & 7) : n;
        *(GAS u32x4*)(WT + (size_t)(drow0 + nr) * dld + dcol0 + k0 + 8 * c) = o; }
    LDS_WAIT();
}
constexpr int CV_J0 = 2048, CV_J1 = 768, CV_J2 = 32, CV_JG = 1024, CV_JC = 256, CV_JD = 1024, CV_JE = 2816, CV_JF = 2816;
constexpr int CV_PER_LAYER = CV_J0 + CV_J1 + CV_J2 + 4 * CV_JG + 4 * CV_JC + CV_JD + 2 * CV_JE + CV_JF;
struct Args { const float* in[N_IN]; float* out; unsigned char* ws; int ph_lo, ph_hi, flags, pad; };
typedef Args Ptrs;
__device__ __forceinline__ void cvt_dispatch(const Ptrs& P, int it, LAS float* scr, int lane) {
    const int l = it / CV_PER_LAYER; int r = it % CV_PER_LAYER;
    unsigned char* wl = P.ws + WS_W + (size_t)l * WL_STRIDE;
    bf16_t* WA = (bf16_t*)(wl + WL_A); bf16_t* WC = (bf16_t*)(wl + WL_C); bf16_t* WD = (bf16_t*)(wl + WL_D); bf16_t* WE = (bf16_t*)(wl + WL_E); bf16_t* WF = (bf16_t*)(wl + WL_F);
    const float* w_in = P.in[I_W_IN] + (size_t)l * DM * INW; const float* gmix = P.in[I_NORM_MIX] + (size_t)l * DM; const float* gffn = P.in[I_NORM_FFN] + (size_t)l * DM;
    if (r < CV_J0) { const int kb = r / 64, nb = r % 64; cvt_item(w_in, INW, 64 * kb, 64 * nb, WA, DM, 64 * nb, 0, gmix, 64, scr, lane); return; } r -= CV_J0;
    if (r < CV_J1) { const int kb = r / 24, nb = r % 24; cvt_item(w_in, INW, 64 * kb, 4104 + 64 * nb, WA, DM, 4096 + 64 * nb, 0, gmix, 64, scr, lane); return; } r -= CV_J1;
    if (r < CV_J2) { const int kb = r; cvt_item(w_in, INW, 64 * kb, 4096, WA, DM, 5632, 0, gmix, 8, scr, lane); return; } r -= CV_J2;
    if (r < 4 * CV_JG) { const int g = r / CV_JG, q = r % CV_JG, kb = q / 32, nb = q % 32;
        cvt_item(P.in[I_W_GATE] + ((size_t)l * 4 + g) * DM * DM, DM, 64 * kb, 64 * nb, WA, DM, 5888 + 2048 * g + 64 * nb, 0, gmix, 64, scr, lane, false); return; } r -= 4 * CV_JG;
    if (r < 4 * CV_JC) { const int g = r / CV_JC, q = r % CV_JC, kb = q / 32, nb = q % 32;
        cvt_item(P.in[I_W_BRANCH] + ((size_t)l * 4 + g) * BW * DM, DM, 64 * kb, 64 * nb, WC, DM, 64 * nb, 512 * g, nullptr, 64, scr, lane); return; } r -= 4 * CV_JC;
    if (r < CV_JD) { const int kb = r / 32, nb = r % 32; cvt_item(P.in[I_W_OUT] + (size_t)l * DM * DM, DM, 64 * kb, 64 * nb, WD, DM, 64 * nb, 0, nullptr, 64, scr, lane); return; } r -= CV_JD;
    if (r < 2 * CV_JE) { const int half = r / CV_JE, q = r % CV_JE, kb = q / 88, nb = q % 88, c0 = 64 * nb;
        cvt_item(P.in[half ? I_W_FFN_UP : I_W_FFN_GATE] + (size_t)l * DM * FF, FF, 64 * kb, c0, WE, DM, (c0 >> 7) * 256 + (c0 & 127) + 128 * half, 0, gffn, 64, scr, lane); return; } r -= 2 * CV_JE;
    { const int kb = r / 32, nb = r % 32; cvt_item(P.in[I_W_FFN_DOWN] + (size_t)l * FF * DM, DM, 64 * kb, 64 * nb, WF, FF, 64 * nb, 0, nullptr, 64, scr, lane); }
}
#ifndef PRO_STATIC
#define PRO_STATIC 64
#endif
#ifndef CV_E_PW
#define CV_E_PW 0
#endif
#ifndef CV_A_PW
#define CV_A_PW 0
#endif
constexpr int CV_TAIL_E = 128 * NWAVES * CV_E_PW, CV_TAIL_A = 32 * NWAVES * CV_A_PW, CV_TAIL_TOTAL = CV_TAIL_E + CV_TAIL_A;
static_assert(CV_TAIL_TOTAL <= CV_PER_LAYER, "tail shares");
__device__ __forceinline__ void cvt_tail(const Ptrs& P, int layer, int first, int nw, int per_wave, int widx, LAS unsigned char* lds, int wave, int lane) {
    LAS float* scr = (LAS float*)(lds + wave * (64 * 65 * 4));
    for (int k = 0; k < per_wave; ++k) cvt_dispatch(P, layer * CV_PER_LAYER + first + widx + nw * k, scr, lane);
}
__device__ __forceinline__ void x_row_init(const float* xrow, bf16_t* xbrow, float* strow, int lane) {
    const GAS f32x4* xr = (const GAS f32x4*)xrow + 2 * lane;
    float ss = 0.f;
#pragma unroll
    for (int j = 0; j < 4; ++j) { const f32x4 a = xr[128 * j], b = xr[128 * j + 1];
        ss += ((a.x * a.x + a.y * a.y) + (a.z * a.z + a.w * a.w)) + ((b.x * b.x + b.y * b.y) + (b.z * b.z + b.w * b.w));
        *(GAS u32x4*)(xbrow + 512 * j + 8 * lane) = pack8(a, b); }
    ss = wave_sum(ss);
    if (lane < 32) strow[lane] = lane == 0 ? ss : 0.f;
}
__device__ __forceinline__ void p0_prologue(const Ptrs& P, LAS unsigned char* lds, int vcu, int G, int wave, int lane) {
    LAS float* scr = (LAS float*)(lds + wave * (64 * 65 * 4));
    const int gw = vcu * NWAVES + wave, NGW = G * NWAVES;
    constexpr int REST = CV_PER_LAYER - CV_TAIL_TOTAL;
    constexpr int TOTAL = CV_PER_LAYER + (DEPTH - 1) * REST;
    const int nstat = (NGW * PRO_STATIC < TOTAL) ? NGW * PRO_STATIC : TOTAL;
    for (int it = gw; it < nstat; it += NGW) {
        if (it < CV_PER_LAYER) cvt_dispatch(P, it, scr, lane);
        else { const int r = it - CV_PER_LAYER, l = 1 + r / REST, q = CV_TAIL_TOTAL + r % REST; cvt_dispatch(P, l * CV_PER_LAYER + q, scr, lane); } }
    { unsigned* qctr = (unsigned*)(P.ws + WS_CTL + 32 * 1024);
      const int ntail = TOTAL - nstat, per = (ntail + 7) / 8, g0 = (int)(blockIdx.x & 7);
      for (int gg = 0; gg < 8 && ntail > 0; ++gg) { const int grp = (g0 + gg) & 7; const int lo = nstat + grp * per; int cnt = ntail - grp * per; cnt = cnt < 0 ? 0 : (cnt > per ? per : cnt);
          for (;;) { unsigned k = 0; if (lane == 0) k = __hip_atomic_fetch_add(qctr + 64 * grp, 1u, __ATOMIC_RELAXED, __HIP_MEMORY_SCOPE_AGENT);
              k = (unsigned)__builtin_amdgcn_readfirstlane((int)k); if ((int)k >= cnt) break;
              const int it = lo + (int)k;
              if (it < CV_PER_LAYER) cvt_dispatch(P, it, scr, lane);
              else { const int r = it - CV_PER_LAYER, l = 1 + r / REST, q = CV_TAIL_TOTAL + r % REST; cvt_dispatch(P, l * CV_PER_LAYER + q, scr, lane); } } } }
    { bf16_t* WsB = (bf16_t*)(P.ws + WS_SMALLW); const float* w_s = P.in[I_GM_W_S];
      for (int i = gw * 64 + lane; i < DEPTH * 4 * 16384; i += NGW * 64) { const int t = (i >> 7) & 127, p = i & 127; WsB[i] = p <= t ? f2bf(w_s[i]) : (bf16_t)0; }
      bf16_t* WT = (bf16_t*)(P.ws + WS_SMALLW + 1 * MiB);
      for (int i = gw * 64 + lane; i < DEPTH * 2 * 4 * 16384; i += NGW * 64) { const int c = i & 127, d = (i >> 7) & 127, g = (i >> 14) & 3, which = (i >> 16) & 1, l = i >> 17;
          WT[i] = f2bf((which ? P.in[I_LRU_W_I] : P.in[I_LRU_W_R])[((size_t)(l * 4 + g) * 128 + c) * 128 + d]); } }
    { float* lam8 = (float*)(P.ws + WS_SMALLW + 2 * MiB);
      for (int i = gw * 64 + lane; i < DEPTH * 512; i += NGW * 64) lam8[i] = 8.0f * 1.4426950408889634f * logsigf_(P.in[I_LRU_LAMBDA][i]); }
    bf16_t* xb = (bf16_t*)(P.ws + WS_XB); float* st = (float*)(P.ws + WS_STATS);
    for (int m = gw; m < SEQ; m += NGW) x_row_init(P.in[I_X] + (size_t)m * DM, xb + (size_t)m * DM, st + (size_t)m * 32, lane);
}

#ifdef TPROBE
#ifndef TP_OFF
#define TP_OFF 0
#endif
#define TP_BEGIN(k) do { if ((k) == TPROBE) tp_t0 = __builtin_amdgcn_s_memrealtime(); } while (0)
#define TP_END(k) do { if ((k) == TPROBE) tp_sum += (unsigned)(__builtin_amdgcn_s_memrealtime() - tp_t0); } while (0)
#else
#define TP_BEGIN(k) do {} while (0)
#define TP_END(k) do {} while (0)
#endif
#ifndef E_HALF_TAIL
#define E_HALF_TAIL 0
#endif
#if E_HALF_TAIL
#define E_ORDER pg8::HalfTailOrder
#else
#define E_ORDER GEMM_ORDER
#endif
#ifndef GEMM_ORDER
#define GEMM_ORDER pg8::PanelOrder
#endif
#ifndef REP_P
#define REP_P 1
#endif
#ifndef REP_A
#define REP_A 1
#endif
#ifndef REP_M1
#define REP_M1 1
#endif
#ifndef REP_M2
#define REP_M2 1
#endif
#ifndef REP_M3
#define REP_M3 1
#endif
#ifndef REP_C
#define REP_C 1
#endif
#ifndef REP_E
#define REP_E 1
#endif

constexpr int TS = 136;
#define MFMA16(cf, rf, acc) __builtin_amdgcn_mfma_f32_16x16x32_bf16((cf), (rf), (acc), 0, 0, 0)
__device__ __forceinline__ s16x4 tr16(const LAS bf16_t* p) { return __builtin_amdgcn_ds_read_tr16_b64_v4i16((LAS s16x4*)p); }
__device__ __forceinline__ bf16x8 tr_frag(const LAS bf16_t* tile, int rlo, int rhi, int c0, int lane) {
    const int qq = (lane & 15) >> 2, pp = lane & 3;
    const s16x4 lo = tr16(tile + (rlo + qq) * TS + c0 + 4 * pp), hi = tr16(tile + (rhi + qq) * TS + c0 + 4 * pp);
    return __builtin_shufflevector(lo, hi, 0, 1, 2, 3, 4, 5, 6, 7);
}
__device__ __forceinline__ void unpack8(const u32x4 w, float (&x)[8]) { x[0] = bflo(w.x); x[1] = bfhi(w.x); x[2] = bflo(w.y); x[3] = bfhi(w.y); x[4] = bflo(w.z); x[5] = bfhi(w.z); x[6] = bflo(w.w); x[7] = bfhi(w.w); }
__device__ __forceinline__ u32x4 pack8f(const float (&x)[8]) { u32x4 w; w.x = cvt_pk_bf16(x[0], x[1]); w.y = cvt_pk_bf16(x[2], x[3]); w.z = cvt_pk_bf16(x[4], x[5]); w.w = cvt_pk_bf16(x[6], x[7]); return w; }

__device__ __forceinline__ void mix_gmlp(const Args& args, int l, LAS unsigned char* lds, int unit, int tid) {
    const int c = unit >> 2, g = unit & 3, lane = tid & 63, w = __builtin_amdgcn_readfirstlane(tid >> 6), fr = lane & 15, fq = lane >> 4;
    const bf16_t* proj = (const bf16_t*)(args.ws + WS_PROJ); bf16_t* y = (bf16_t*)(args.ws + WS_Y);
    const float* g_v = args.in[I_GM_NORM_V] + l * 512; const float* b_s = args.in[I_GM_B_S] + l * 512;
    const bf16_t* WsB = (const bf16_t*)(args.ws + WS_SMALLW) + (size_t)(l * 4 + g) * 16384;
    LAS bf16_t* vt = (LAS bf16_t*)lds;
    const float* gvs = (const float*)(args.ws + WS_GVS);
    u32x4 rawv[4];
#pragma unroll
    for (int i = 0; i < 4; ++i) { const int idx = lane + 64 * i; rawv[i] = *(const u32x4*)(proj + ((size_t)c * 128 + 16 * w + (idx >> 4)) * PROJ_LD + 512 + g * 128 + 8 * (idx & 15)); }
    const int rt = 16 * w + fr; const size_t row = (size_t)c * 128 + rt;
    bf16x8 wsf[4]; u32x2 uraw[8];
#pragma unroll
    for (int ks = 0; ks < 4; ++ks) wsf[ks] = *(const bf16x8*)(WsB + rt * 128 + 32 * ks + 8 * fq);
#pragma unroll
    for (int nb = 0; nb < 8; ++nb) uraw[nb] = *(const u32x2*)(proj + row * PROJ_LD + g * 128 + 16 * nb + 4 * fq);
    const float bias = b_s[g * 128 + rt];
    LAS float* rtab = (LAS float*)(lds + 128 * TS * 2) + 16 * w;
    if (lane < 16) { const f32x4* p = (const f32x4*)(gvs + ((size_t)c * 128 + 16 * w + lane) * 8); const f32x4 a = p[0], b = p[1];
        rtab[lane] = rsqrtf((((a.x + a.y) + (a.z + a.w)) + ((b.x + b.y) + (b.z + b.w))) * (1.0f / 512.0f) + EPS); }
    LDS_WAIT();
#pragma unroll
    for (int i = 0; i < 4; ++i) { const int idx = lane + 64 * i, pr = idx >> 4, ck = idx & 15; const float rstd = rtab[pr];
        const f32x4 g0 = *(const f32x4*)(g_v + g * 128 + 8 * ck), g1 = *(const f32x4*)(g_v + g * 128 + 8 * ck + 4);
        float x[8]; unpack8(rawv[i], x);
#pragma unroll
        for (int j = 0; j < 4; ++j) { x[j] = gelu_tanh(x[j]) * rstd * g0[j]; x[4 + j] = gelu_tanh(x[4 + j]) * rstd * g1[j]; }
        *(LAS u32x4*)(vt + (16 * w + pr) * TS + 8 * ck) = pack8f(x); }
    __syncthreads();
    f32x4 acc[8];
#pragma unroll
    for (int nb = 0; nb < 8; ++nb) acc[nb] = (f32x4){0.f, 0.f, 0.f, 0.f};
#pragma unroll
    for (int ks = 0; ks < 4; ++ks) if (32 * ks <= 16 * w + 15) {
        const bf16x8 a = wsf[ks];
#pragma unroll
        for (int nb = 0; nb < 8; ++nb) { const bf16x8 b = tr_frag(vt, 32 * ks + 8 * fq, 32 * ks + 8 * fq + 4, 16 * nb, lane); acc[nb] = MFMA16(b, a, acc[nb]); } }
#pragma unroll
    for (int nb = 0; nb < 8; ++nb) { const int col = g * 128 + 16 * nb + 4 * fq; const u32x2 uu = uraw[nb];
        const float u0 = gelu_tanh(bflo(uu.x)), u1 = gelu_tanh(bfhi(uu.x)), u2 = gelu_tanh(bflo(uu.y)), u3 = gelu_tanh(bfhi(uu.y));
        u32x2 o; o.x = cvt_pk_bf16(u0 * (acc[nb][0] + bias), u1 * (acc[nb][1] + bias)); o.y = cvt_pk_bf16(u2 * (acc[nb][2] + bias), u3 * (acc[nb][3] + bias));
        *(u32x2*)(y + row * DM + col) = o; }
    __syncthreads();
}

constexpr int LRU_RAW = 0, LRU_XCB = 35840, LRU_A = 70656, LRU_BX = 103424, LRU_SEGA = 136192, LRU_SEGH = 138240, LRU_CARRY = 140288;
constexpr size_t LRU_HL = 0, LRU_PL = 16 * MiB;
__device__ __forceinline__ void mix_lru0(const Args& args, int l, LAS unsigned char* lds, int unit, int tid) {
    const int c = unit >> 2, g = unit & 3, lane = tid & 63, w = __builtin_amdgcn_readfirstlane(tid >> 6), fr = lane & 15, fq = lane >> 4, t0 = c * 128;
    const bf16_t* proj = (const bf16_t*)(args.ws + WS_PROJ);
    f32x2* AH = (f32x2*)(args.ws + WS_LRU_AH); float* HL = (float*)(args.ws + WS_NAIVE + LRU_HL); float* PL = (float*)(args.ws + WS_NAIVE + LRU_PL);
    const bf16_t* WT = (const bf16_t*)(args.ws + WS_SMALLW + 1 * MiB);
    const bf16_t* WrT = WT + (size_t)((l * 2 + 0) * 4 + g) * 16384; const bf16_t* WiT = WT + (size_t)((l * 2 + 1) * 4 + g) * 16384;
    const float* cw = args.in[I_LRU_CONV_W] + l * 4 * 512; const float* cb = args.in[I_LRU_CONV_B] + l * 512;
    const float* b_r = args.in[I_LRU_B_R] + l * 512; const float* b_i = args.in[I_LRU_B_I] + l * 512; const float* lam8 = (const float*)(args.ws + WS_SMALLW + 2 * MiB) + l * 512;
    LAS bf16_t* raw = (LAS bf16_t*)(lds + LRU_RAW); LAS bf16_t* xcb = (LAS bf16_t*)(lds + LRU_XCB);
    LAS float* Al = (LAS float*)(lds + LRU_A); LAS float* Bl = (LAS float*)(lds + LRU_BX);
    LAS float* segA = (LAS float*)(lds + LRU_SEGA); LAS float* segH = (LAS float*)(lds + LRU_SEGH);
    u32x4 wq[4];
#pragma unroll
    for (int i = 0; i < 4; ++i) { const int idx = tid + NTHREADS * i; wq[i] = *(const u32x4*)(((idx >> 10) ? WiT : WrT) + ((idx >> 4) & 63) * 128 + 8 * (idx & 15)); }
    for (int idx = tid; idx < 131 * 16; idx += NTHREADS) { const int r = idx >> 4, ck = idx & 15, t = t0 - 3 + r;
        u32x4 v = (u32x4){0u, 0u, 0u, 0u}; if (t >= 0) v = *(const u32x4*)(proj + (size_t)t * PROJ_LD + 2 * 512 + g * 128 + 8 * ck);
        *(LAS u32x4*)(raw + r * TS + 8 * ck) = v; }
    __syncthreads();
    for (int idx = tid; idx < 128 * 16; idx += NTHREADS) { const int t = idx >> 4, ck = idx & 15, ch0 = g * 128 + 8 * ck;
        float a8[8]; { const f32x4 c0 = *(const f32x4*)(cb + ch0), c1 = *(const f32x4*)(cb + ch0 + 4);
#pragma unroll
            for (int j = 0; j < 4; ++j) { a8[j] = c0[j]; a8[4 + j] = c1[j]; } }
#pragma unroll
        for (int k = 0; k < 4; ++k) { float x[8]; unpack8(*(const LAS u32x4*)(raw + (t + k) * TS + 8 * ck), x);
            const f32x4 w0 = *(const f32x4*)(cw + k * 512 + ch0), w1 = *(const f32x4*)(cw + k * 512 + ch0 + 4);
#pragma unroll
            for (int j = 0; j < 4; ++j) { a8[j] += w0[j] * x[j]; a8[4 + j] += w1[j] * x[4 + j]; } }
        *(LAS u32x4*)(xcb + t * TS + 8 * ck) = pack8f(a8); }
    __syncthreads();
    const int rt = 16 * w + fr;
#pragma unroll 1
    for (int hd = 0; hd < 2; ++hd) {
#pragma unroll
        for (int i = 0; i < 4; ++i) { const int idx = tid + NTHREADS * i; *(LAS u32x4*)(raw + (idx >> 4) * TS + 8 * (idx & 15)) = wq[i]; }
        if (hd == 0) {
#pragma unroll
            for (int i = 0; i < 4; ++i) { const int idx = tid + NTHREADS * i; wq[i] = *(const u32x4*)(((idx >> 10) ? WiT : WrT) + (64 + ((idx >> 4) & 63)) * 128 + 8 * (idx & 15)); } }
        __syncthreads();
        f32x4 aR[4], aI[4];
#pragma unroll
        for (int nb = 0; nb < 4; ++nb) { aR[nb] = (f32x4){0.f, 0.f, 0.f, 0.f}; aI[nb] = (f32x4){0.f, 0.f, 0.f, 0.f}; }
#pragma unroll
        for (int ks = 0; ks < 4; ++ks) { const bf16x8 a = *(const LAS bf16x8*)(xcb + rt * TS + 32 * ks + 8 * fq);
#pragma unroll
            for (int nb = 0; nb < 4; ++nb) {
                const bf16x8 bR = *(const LAS bf16x8*)(raw + (16 * nb + fr) * TS + 32 * ks + 8 * fq), bI = *(const LAS bf16x8*)(raw + (64 + 16 * nb + fr) * TS + 32 * ks + 8 * fq);
                aR[nb] = MFMA16(bR, a, aR[nb]); aI[nb] = MFMA16(bI, a, aI[nb]); } }
#pragma unroll
        for (int nb = 0; nb < 4; ++nb) { const int d0 = 64 * hd + 16 * nb + 4 * fq, ch = g * 128 + d0;
            const f32x4 br = *(const f32x4*)(b_r + ch), bi = *(const f32x4*)(b_i + ch), lm = *(const f32x4*)(lam8 + ch);
            const u32x2 xw = *(const LAS u32x2*)(xcb + rt * TS + d0); const float xc[4] = {bflo(xw.x), bfhi(xw.x), bflo(xw.y), bfhi(xw.y)};
            f32x4 av, bv;
#pragma unroll
            for (int j = 0; j < 4; ++j) { const float r = sigmoidf_(aR[nb][j] + br[j]), ii = sigmoidf_(aI[nb][j] + bi[j]);
                const float a = __builtin_amdgcn_exp2f(r * lm[j]); av[j] = a; bv[j] = __builtin_amdgcn_sqrtf(fmaxf(1.0f - a * a, 0.f)) * (ii * xc[j]); }
            *(LAS f32x4*)(Al + rt * 64 + 16 * nb + 4 * fq) = av; *(LAS f32x4*)(Bl + rt * 64 + 16 * nb + 4 * fq) = bv; }
        __syncthreads();
        float ap = 1.f, h = 0.f;
#pragma unroll
        for (int i = 0; i < 16; ++i) { const float a = Al[(16 * w + i) * 64 + lane], b = Bl[(16 * w + i) * 64 + lane]; h = a * h + b; ap *= a; }
        segA[w * 64 + lane] = ap; segH[w * 64 + lane] = h;
        __syncthreads();
        float hin = 0.f, pin = 1.f;
        for (int s = 0; s < w; ++s) { const float a = segA[s * 64 + lane]; hin = a * hin + segH[s * 64 + lane]; pin *= a; }
        const int chn = g * 128 + 64 * hd + lane;
#pragma unroll
        for (int i = 0; i < 16; ++i) { const int t = 16 * w + i; const float a = Al[t * 64 + lane], b = Bl[t * 64 + lane]; hin = a * hin + b; pin *= a;
            HL[(size_t)(t0 + t) * 512 + chn] = hin; PL[(size_t)(t0 + t) * 512 + chn] = pin; }
        if (w == 7) AH[(size_t)c * 512 + chn] = (f32x2){pin, hin};
        __syncthreads();
    }
}
__device__ __forceinline__ void mix_lru1(const Args& args, int l, LAS unsigned char* lds, int unit, int tid) {
    const int c = unit >> 2, g = unit & 3, t0 = c * 128;
    const bf16_t* proj = (const bf16_t*)(args.ws + WS_PROJ); bf16_t* y = (bf16_t*)(args.ws + WS_Y);
    const f32x2* AH = (const f32x2*)(args.ws + WS_LRU_AH); const float* HL = (const float*)(args.ws + WS_NAIVE + LRU_HL); const float* PL = (const float*)(args.ws + WS_NAIVE + LRU_PL);
    LAS float* carry = (LAS float*)(lds + LRU_CARRY);
    const int cq = tid & 31, r0 = tid >> 5, chn = g * 128 + 4 * cq;
    f32x4 hl[8], pl[8]; u32x2 gt[8];
#pragma unroll
    for (int i = 0; i < 8; ++i) { const size_t row = (size_t)t0 + 16 * i + r0; hl[i] = *(const f32x4*)(HL + row * 512 + chn); pl[i] = *(const f32x4*)(PL + row * 512 + chn); gt[i] = *(const u32x2*)(proj + row * PROJ_LD + 3 * 512 + chn); }
    { const int ch = tid & 127, part = tid >> 7; const f32x2* p = AH + g * 128 + ch; LAS f32x2* parts = (LAS f32x2*)(lds + LRU_CARRY + 512);
      f32x2 v[16];
#pragma unroll
      for (int i = 0; i < 16; ++i) v[i] = (part * 16 + i < c) ? p[(size_t)(part * 16 + i) * 512] : (f32x2){1.f, 0.f};
      float pa = 1.f, ph = 0.f;
#pragma unroll
      for (int i = 0; i < 16; ++i) { ph = v[i].x * ph + v[i].y; pa = v[i].x * pa; }
      parts[part * 128 + ch] = (f32x2){pa, ph}; }
    __syncthreads();
    if (tid < 128) { const LAS f32x2* parts = (const LAS f32x2*)(lds + LRU_CARRY + 512); float hc = 0.f;
#pragma unroll
        for (int q = 0; q < 4; ++q) { const f32x2 v = parts[q * 128 + tid]; hc = v.x * hc + v.y; }
        carry[tid] = hc; }
    __syncthreads();
    const f32x4 cy = *(const LAS f32x4*)(carry + 4 * cq);
#pragma unroll
    for (int i = 0; i < 8; ++i) { const size_t row = (size_t)t0 + 16 * i + r0; const f32x4 hv = hl[i] + pl[i] * cy;
        u32x2 o; o.x = cvt_pk_bf16(hv[0] * gelu_tanh(bflo(gt[i].x)), hv[1] * gelu_tanh(bfhi(gt[i].x))); o.y = cvt_pk_bf16(hv[2] * gelu_tanh(bflo(gt[i].y)), hv[3] * gelu_tanh(bfhi(gt[i].y)));
        *(u32x2*)(y + row * DM + 512 + chn) = o; }
    __syncthreads();
}
constexpr int AT_K = 0, AT_V = 17408, AT_KR = 34816, AT_DONE = 35072;
constexpr float AT_RMIN = -127.0f;
__device__ __forceinline__ void mix_attn(const Args& args, int l, LAS unsigned char* lds, int unit, int tid) {
    const int h = unit & 3, qt = unit >> 2, lane = tid & 63, w = __builtin_amdgcn_readfirstlane(tid >> 6), fr = lane & 15, fq = lane >> 4, q0 = qt * 128;
    const int trow = q0 + 16 * w + fr;
    const bf16_t* proj = (const bf16_t*)(args.ws + WS_PROJ); bf16_t* y = (bf16_t*)(args.ws + WS_Y);
    const float* g_q = args.in[I_SB_NORM_Q] + l * 128; const float* g_k = args.in[I_SB_NORM_K] + l * 128;
    LAS bf16_t* Kt = (LAS bf16_t*)(lds + AT_K); LAS bf16_t* Vt = (LAS bf16_t*)(lds + AT_V); LAS float* kr = (LAS float*)(lds + AT_KR); LAS unsigned* done = (LAS unsigned*)(lds + AT_DONE);
    u32x4 pk[2], pv[2];
#pragma unroll
    for (int i = 0; i < 2; ++i) { const int idx = tid + NTHREADS * i, r = idx >> 4, ck = idx & 15; const size_t s = (size_t)64 * (2 * qt + 1) + r;
        pk[i] = *(const u32x4*)(proj + s * PROJ_LD + 9 * 512 + h * 128 + 8 * ck); pv[i] = *(const u32x4*)(proj + s * PROJ_LD + 10 * 512 + h * 128 + 8 * ck); }
    bf16x8 qf[4];
    { float x[4][8]; float ss = 0.f;
#pragma unroll
      for (int ks = 0; ks < 4; ++ks) { unpack8(*(const u32x4*)(proj + (size_t)trow * PROJ_LD + 8 * 512 + h * 128 + 32 * ks + 8 * fq), x[ks]);
#pragma unroll
          for (int e = 0; e < 8; ++e) ss += x[ks][e] * x[ks][e]; }
      ss += __shfl_xor(ss, 16); ss += __shfl_xor(ss, 32);
      const float rstd = rsqrtf(ss * (1.0f / 128.0f) + EPS) * (0.08838834764831845f * 1.4426950408889634f);
#pragma unroll
      for (int ks = 0; ks < 4; ++ks) { const int d0 = 32 * ks + 8 * fq;
          const f32x4 a0 = *(const f32x4*)(g_q + d0), a1 = *(const f32x4*)(g_q + d0 + 4), b0 = *(const f32x4*)(g_k + d0), b1 = *(const f32x4*)(g_k + d0 + 4);
#pragma unroll
          for (int e = 0; e < 4; ++e) { x[ks][e] *= rstd * a0[e] * b0[e]; x[ks][4 + e] *= rstd * a1[e] * b1[e]; }
          qf[ks] = __builtin_bit_cast(bf16x8, pack8f(x[ks])); } }
    f32x4 o[8];
#pragma unroll
    for (int db = 0; db < 8; ++db) o[db] = (f32x4){0.f, 0.f, 0.f, 0.f};
    float R = 0.f; bool mydone = false;
    for (int kt = 2 * qt + 1; kt >= 0; --kt) {
#pragma unroll
        for (int i = 0; i < 2; ++i) { const int idx = tid + NTHREADS * i, r = idx >> 4, ck = idx & 15;
            *(LAS u32x4*)(Kt + r * TS + 8 * ck) = pk[i]; *(LAS u32x4*)(Vt + r * TS + 8 * ck) = pv[i];
            float x[8]; unpack8(pk[i], x); float ss = 0.f;
#pragma unroll
            for (int e = 0; e < 8; ++e) ss += x[e] * x[e];
            ss += __shfl_xor(ss, 1); ss += __shfl_xor(ss, 2); ss += __shfl_xor(ss, 4); ss += __shfl_xor(ss, 8);
            if (ck == 0) kr[r] = rsqrtf(ss * (1.0f / 128.0f) + EPS); }
        if (kt > 0) {
#pragma unroll
            for (int i = 0; i < 2; ++i) { const int idx = tid + NTHREADS * i, r = idx >> 4, ck = idx & 15; const size_t s = (size_t)64 * (kt - 1) + r;
                pk[i] = *(const u32x4*)(proj + s * PROJ_LD + 9 * 512 + h * 128 + 8 * ck); pv[i] = *(const u32x4*)(proj + s * PROJ_LD + 10 * 512 + h * 128 + 8 * ck); } }
        __syncthreads();
        const bool active = !mydone && (64 * kt < q0 + 16 * w + 15);
        if (active) {
            f32x4 s4[4];
#pragma unroll
            for (int nb = 0; nb < 4; ++nb) s4[nb] = (f32x4){0.f, 0.f, 0.f, 0.f};
#pragma unroll
            for (int ks = 0; ks < 4; ++ks)
#pragma unroll
                for (int nb = 0; nb < 4; ++nb) { const bf16x8 cf = *(const LAS bf16x8*)(Kt + (16 * nb + fr) * TS + 32 * ks + 8 * fq); s4[nb] = MFMA16(cf, qf[ks], s4[nb]); }
            float ln[4][4], zz[4][4], RT[4], sfq[4];
#pragma unroll
            for (int nb = 0; nb < 4; ++nb) { const f32x4 k4 = *(const LAS f32x4*)(kr + 16 * nb + 4 * fq); float gs = 0.f;
#pragma unroll
                for (int j = 0; j < 4; ++j) { const int s = 64 * kt + 16 * nb + 4 * fq + j; const bool valid = s < trow; const float z = s4[nb][j] * k4[j];
                    const float sp = fmaxf(z, 0.f) + __builtin_amdgcn_logf(1.0f + __builtin_amdgcn_exp2f(-fabsf(z)));
                    ln[nb][j] = valid ? -sp : 0.f; zz[nb][j] = valid ? z : -1.0e30f; gs += ln[nb][j]; }
                const float b = __shfl_xor(gs, 16); const float pair = gs + b; const float po = __shfl_xor(pair, 32);
                RT[nb] = pair + po; sfq[nb] = ((fq & 1) ? 0.f : b) + ((fq & 2) ? 0.f : po); }
            float att[4][4]; float above = 0.f;
#pragma unroll
            for (int nb = 3; nb >= 0; --nb) { float rem = R + above + sfq[nb];
#pragma unroll
                for (int j = 3; j >= 0; --j) { att[nb][j] = __builtin_amdgcn_exp2f(zz[nb][j] + ln[nb][j] + rem); rem += ln[nb][j]; }
                above += RT[nb]; }
            R += above;
#pragma unroll
            for (int ksv = 0; ksv < 2; ++ksv) { u32x4 pw; pw.x = cvt_pk_bf16(att[2 * ksv][0], att[2 * ksv][1]); pw.y = cvt_pk_bf16(att[2 * ksv][2], att[2 * ksv][3]);
                pw.z = cvt_pk_bf16(att[2 * ksv + 1][0], att[2 * ksv + 1][1]); pw.w = cvt_pk_bf16(att[2 * ksv + 1][2], att[2 * ksv + 1][3]);
                const bf16x8 rf = __builtin_bit_cast(bf16x8, pw);
#pragma unroll
                for (int db = 0; db < 8; ++db) { const bf16x8 cf = tr_frag(Vt, 32 * ksv + 4 * fq, 32 * ksv + 16 + 4 * fq, 16 * db, lane); o[db] = MFMA16(cf, rf, o[db]); } }
            mydone = __all(R < AT_RMIN);
        }
        if (lane == 0) done[w] = mydone ? 1u : 0u;
        __syncthreads();
        unsigned alld = 1u;
#pragma unroll
        for (int i = 0; i < 8; ++i) alld &= done[i];
        if (alld) break;
    }
#pragma unroll
    for (int db = 0; db < 8; ++db) { u32x2 ov; ov.x = cvt_pk_bf16(o[db][0], o[db][1]); ov.y = cvt_pk_bf16(o[db][2], o[db][3]);
        *(u32x2*)(y + (size_t)trow * DM + 1536 + h * 128 + 16 * db + 4 * fq) = ov; }
    __syncthreads();
}

constexpr size_t ML_DC = 0, ML_CP = 16 * MiB, ML_DN = 24 * MiB, ML_NP = 24 * MiB + 256 * 1024, ML_SC = 24 * MiB + 512 * 1024;
struct ConvRaw { u32x4 v[5]; };
__device__ __forceinline__ void conv_load(ConvRaw& R, const bf16_t* proj, int col0, int t0, int tid) {
#pragma unroll
    for (int i = 0; i < 5; ++i) { const int idx = tid + NTHREADS * i, r = idx >> 4, ck = idx & 15, t = t0 - 3 + r;
        R.v[i] = (u32x4){0u, 0u, 0u, 0u}; if (idx < 131 * 16 && t >= 0) R.v[i] = *(const u32x4*)(proj + (size_t)t * PROJ_LD + col0 + 8 * ck); }
}
__device__ __forceinline__ void conv_tile(const ConvRaw& R, const float* cw, int cwstride, const float* cb, LAS bf16_t* raw, LAS bf16_t* outt, float post, int tid) {
#pragma unroll
    for (int i = 0; i < 5; ++i) { const int idx = tid + NTHREADS * i, r = idx >> 4, ck = idx & 15; if (idx < 131 * 16) *(LAS u32x4*)(raw + r * TS + 8 * ck) = R.v[i]; }
    __syncthreads();
    for (int idx = tid; idx < 128 * 16; idx += NTHREADS) { const int t = idx >> 4, ck = idx & 15;
        float a8[8]; { const f32x4 c0 = *(const f32x4*)(cb + 8 * ck), c1 = *(const f32x4*)(cb + 8 * ck + 4);
#pragma unroll
            for (int j = 0; j < 4; ++j) { a8[j] = c0[j]; a8[4 + j] = c1[j]; } }
#pragma unroll
        for (int k = 0; k < 4; ++k) { float x[8]; unpack8(*(const LAS u32x4*)(raw + (t + k) * TS + 8 * ck), x);
            const f32x4 w0 = *(const f32x4*)(cw + k * cwstride + 8 * ck), w1 = *(const f32x4*)(cw + k * cwstride + 8 * ck + 4);
#pragma unroll
            for (int j = 0; j < 4; ++j) { a8[j] += w0[j] * x[j]; a8[4 + j] += w1[j] * x[4 + j]; } }
#pragma unroll
        for (int j = 0; j < 8; ++j) a8[j] = a8[j] * sigmoidf_(a8[j]) * post;
        *(LAS u32x4*)(outt + t * TS + 8 * ck) = pack8f(a8); }
    __syncthreads();
}
constexpr int ML_RAW = 0, ML_T1 = 35840, ML_T2 = 70656, ML_T3 = 105472, ML_ARR = 140288;
__device__ __forceinline__ void mix_ml1(const Args& args, int l, LAS unsigned char* lds, int unit, int tid) {
    const int c = unit >> 2, h = unit & 3, lane = tid & 63, w = __builtin_amdgcn_readfirstlane(tid >> 6), fr = lane & 15, fq = lane >> 4, t0 = c * 128;
    const bf16_t* proj = (const bf16_t*)(args.ws + WS_PROJ); const float* ifg = (const float*)(args.ws + WS_IFG);
    unsigned char* ml = args.ws + WS_ML; float* dC = (float*)(ml + ML_DC); float* dn = (float*)(ml + ML_DN); float* scal = (float*)(ml + ML_SC);
    LAS bf16_t* raw = (LAS bf16_t*)(lds + ML_RAW); LAS bf16_t* KC = (LAS bf16_t*)(lds + ML_T1); LAS bf16_t* VW = (LAS bf16_t*)(lds + ML_T2); LAS float* wl = (LAS float*)(lds + ML_ARR);
    ConvRaw kraw; conv_load(kraw, proj, 5 * 512 + h * 128, t0, tid);
    u32x4 vraw[4];
#pragma unroll
    for (int i = 0; i < 4; ++i) { const int idx = tid + NTHREADS * i, s = idx >> 4, ck = idx & 15; vraw[i] = *(const u32x4*)(proj + (size_t)(t0 + s) * PROJ_LD + 6 * 512 + h * 128 + 8 * ck); }
    if (w == 0) { const float bf = args.in[I_ML_B_F][l * 4 + h], bi = args.in[I_ML_B_I][l * 4 + h]; const int s0 = t0 + 2 * lane;
        const float f0 = logsigf_(ifg[(size_t)s0 * 8 + 4 + h] + bf), f1 = logsigf_(ifg[(size_t)(s0 + 1) * 8 + 4 + h] + bf);
        const float i0 = ifg[(size_t)s0 * 8 + h] + bi, i1 = ifg[(size_t)(s0 + 1) * 8 + h] + bi;
        float P = f0 + f1;
#pragma unroll
        for (int o = 1; o < 64; o <<= 1) { const float n = __shfl_up(P, o); if (lane >= o) P += n; }
        const float blast = __shfl(P, 63); const float g0 = blast - (P - f1) + i0, g1 = blast - P + i1;
        float m = fmaxf(g0, g1);
#pragma unroll
        for (int o = 1; o < 64; o <<= 1) m = fmaxf(m, __shfl_xor(m, o));
        wl[2 * lane] = __expf(g0 - m); wl[2 * lane + 1] = __expf(g1 - m);
        if (lane == 0) { scal[(c * 4 + h) * 4 + 0] = blast; scal[(c * 4 + h) * 4 + 1] = m; } }
    conv_tile(kraw, args.in[I_ML_CONV_W] + l * 4 * 1024 + 512 + h * 128, 1024, args.in[I_ML_CONV_B] + l * 1024 + 512 + h * 128, raw, KC, 0.08838834764831845f, tid);
#pragma unroll
    for (int i = 0; i < 4; ++i) { const int idx = tid + NTHREADS * i, s = idx >> 4, ck = idx & 15; float x[8]; unpack8(vraw[i], x);
        const float ws_ = wl[s];
#pragma unroll
        for (int j = 0; j < 8; ++j) x[j] *= ws_;
        *(LAS u32x4*)(VW + s * TS + 8 * ck) = pack8f(x); }
    __syncthreads();
    f32x4 acc[8];
#pragma unroll
    for (int nb = 0; nb < 8; ++nb) acc[nb] = (f32x4){0.f, 0.f, 0.f, 0.f};
#pragma unroll
    for (int ks = 0; ks < 4; ++ks) { const bf16x8 rf = tr_frag(VW, 32 * ks + 8 * fq, 32 * ks + 8 * fq + 4, 16 * w, lane);
#pragma unroll
        for (int nb = 0; nb < 8; ++nb) { const bf16x8 cf = tr_frag(KC, 32 * ks + 8 * fq, 32 * ks + 8 * fq + 4, 16 * nb, lane); acc[nb] = MFMA16(cf, rf, acc[nb]); } }
    float* dCu = dC + (size_t)(c * 4 + h) * 16384 + (16 * w + fr) * 128 + 4 * fq;
#pragma unroll
    for (int nb = 0; nb < 8; ++nb) *(f32x4*)(dCu + 16 * nb) = acc[nb];
    if (tid < 128) { float s = 0.f;
        for (int ss = 0; ss < 128; ++ss) s += wl[ss] * bf2f(KC[ss * TS + tid]);
        dn[(size_t)(c * 4 + h) * 128 + tid] = s; }
    __syncthreads();
}
__device__ __forceinline__ void mix_ml2(const Args& args, LAS unsigned char* lds, int b, int tid) {
    const int h = b >> 6, sl = b & 63, lane = tid & 63;
    unsigned char* ml = args.ws + WS_ML; const float* dC = (const float*)(ml + ML_DC); unsigned* Cp = (unsigned*)(ml + ML_CP); const float* dn = (const float*)(ml + ML_DN); float* np = (float*)(ml + ML_NP); float* scal = (float*)(ml + ML_SC);
    LAS float* decl = (LAS float*)lds; LAS float* scl = decl + 64;
    const bool ethr = tid < 128; const int e = sl * 256 + (ethr ? tid : 0) * 2; const bool nthr = (sl == 0 && tid < 128);
    f32x2 d[16]; float dnv[16];
#pragma unroll
    for (int i = 0; i < 16; ++i) { const int u = i * 4 + h; d[i] = *(const f32x2*)(dC + (size_t)u * 16384 + e); dnv[i] = nthr ? dn[(size_t)u * 128 + tid] : 0.f; }
    if (tid < 64) { const int u = lane * 4 + h; const float bl = scal[u * 4 + 0], mlc = scal[u * 4 + 1]; float m = 0.f, mydec = 0.f, mysc = 0.f, mym = 0.f;
#pragma unroll
        for (int c = 0; c < 64; ++c) { const float blc = __builtin_bit_cast(float, __builtin_amdgcn_readlane(__builtin_bit_cast(int, bl), c)), mc = __builtin_bit_cast(float, __builtin_amdgcn_readlane(__builtin_bit_cast(int, mlc), c));
            const float mnew = fmaxf(blc + m, mc); const float dec = __expf(blc + m - mnew), sc = __expf(mc - mnew);
            if (lane == c) { mydec = dec; mysc = sc; mym = m; }
            m = mnew; }
        decl[lane] = mydec; scl[lane] = mysc; if (sl == 0) scal[u * 4 + 2] = mym; }
    __syncthreads();
    float C0 = 0.f, C1 = 0.f, n = 0.f;
#pragma unroll 1
    for (int c0 = 0; c0 < 64; c0 += 16) {
        f32x2 dn_[16]; float dnn[16];
        if (c0 + 16 < 64) {
#pragma unroll
            for (int i = 0; i < 16; ++i) { const int u = (c0 + 16 + i) * 4 + h; dn_[i] = *(const f32x2*)(dC + (size_t)u * 16384 + e); dnn[i] = nthr ? dn[(size_t)u * 128 + tid] : 0.f; } }
#pragma unroll
        for (int i = 0; i < 16; ++i) { const int u = (c0 + i) * 4 + h; const float dec = decl[c0 + i], sc = scl[c0 + i];
            if (ethr) Cp[((size_t)u * 16384 + e) >> 1] = cvt_pk_bf16(C0, C1);
            if (nthr) np[(size_t)u * 128 + tid] = n;
            C0 = dec * C0 + sc * d[i].x; C1 = dec * C1 + sc * d[i].y; n = dec * n + sc * dnv[i]; }
#pragma unroll
        for (int i = 0; i < 16; ++i) { d[i] = dn_[i]; dnv[i] = dnn[i]; }
    }
    __syncthreads();
}
__device__ __forceinline__ void mix_ml3(const Args& args, int l, LAS unsigned char* lds, int unit, int tid) {
    const int c = unit >> 2, h = unit & 3, lane = tid & 63, w = __builtin_amdgcn_readfirstlane(tid >> 6), fr = lane & 15, fq = lane >> 4, t0 = c * 128;
    const bf16_t* proj = (const bf16_t*)(args.ws + WS_PROJ); const float* ifg = (const float*)(args.ws + WS_IFG); bf16_t* y = (bf16_t*)(args.ws + WS_Y);
    unsigned char* ml = args.ws + WS_ML; const bf16_t* Cp = (const bf16_t*)(ml + ML_CP) + (size_t)(c * 4 + h) * 16384; const float* npv = (const float*)(ml + ML_NP) + (size_t)(c * 4 + h) * 128; const float* scal = (const float*)(ml + ML_SC);
    LAS bf16_t* raw = (LAS bf16_t*)(lds + ML_RAW); LAS bf16_t* QC = (LAS bf16_t*)(lds + ML_T1); LAS bf16_t* KC = (LAS bf16_t*)(lds + ML_T2); LAS bf16_t* VT = (LAS bf16_t*)(lds + ML_T3);
    LAS float* bcl = (LAS float*)(lds + ML_ARR); LAS float* gil = bcl + 128; LAS float* mtl = bcl + 256; LAS float* scl = bcl + 384; LAS float* npl = bcl + 512;
    ConvRaw qraw, kraw; conv_load(qraw, proj, 4 * 512 + h * 128, t0, tid); conv_load(kraw, proj, 5 * 512 + h * 128, t0, tid);
    u32x4 vraw[4];
#pragma unroll
    for (int i = 0; i < 4; ++i) { const int idx = tid + NTHREADS * i, s = idx >> 4, ck = idx & 15; vraw[i] = *(const u32x4*)(proj + (size_t)(t0 + s) * PROJ_LD + 6 * 512 + h * 128 + 8 * ck); }
    u32x4 cpr[4]; u32x2 opre[8];
#pragma unroll
    for (int i = 0; i < 4; ++i) { const int idx = tid + NTHREADS * i; cpr[i] = *(const u32x4*)(Cp + (idx >> 4) * 128 + 8 * (idx & 15)); }
#pragma unroll
    for (int db = 0; db < 8; ++db) opre[db] = *(const u32x2*)(proj + ((size_t)t0 + 16 * w + fr) * PROJ_LD + 7 * 512 + h * 128 + 16 * db + 4 * fq);
    if (w == 0) { const float bf = args.in[I_ML_B_F][l * 4 + h], bi = args.in[I_ML_B_I][l * 4 + h]; const int s0 = t0 + 2 * lane; const float mprev = scal[(c * 4 + h) * 4 + 2];
        const float f0 = logsigf_(ifg[(size_t)s0 * 8 + 4 + h] + bf), f1 = logsigf_(ifg[(size_t)(s0 + 1) * 8 + 4 + h] + bf);
        const float i0 = ifg[(size_t)s0 * 8 + h] + bi, i1 = ifg[(size_t)(s0 + 1) * 8 + h] + bi;
        float P = f0 + f1;
#pragma unroll
        for (int o = 1; o < 64; o <<= 1) { const float nn = __shfl_up(P, o); if (lane >= o) P += nn; }
        const float bc0 = P - f1, bc1 = P, gi0 = i0 - bc0, gi1 = i1 - bc1;
        float PM = fmaxf(gi0, gi1);
#pragma unroll
        for (int o = 1; o < 64; o <<= 1) { const float nn = __shfl_up(PM, o); if (lane >= o) PM = fmaxf(PM, nn); }
        float pe = __shfl_up(PM, 1); if (lane == 0) pe = -3.0e38f;
        const float M0 = fmaxf(pe, gi0), M1 = PM;
        const float m0 = fmaxf(bc0 + mprev, bc0 + M0), m1 = fmaxf(bc1 + mprev, bc1 + M1);
        bcl[2 * lane] = bc0; bcl[2 * lane + 1] = bc1; gil[2 * lane] = gi0; gil[2 * lane + 1] = gi1; mtl[2 * lane] = m0; mtl[2 * lane + 1] = m1;
        scl[2 * lane] = __expf(bc0 + mprev - m0); scl[2 * lane + 1] = __expf(bc1 + mprev - m1); }
    if (tid >= 128 && tid < 256) npl[tid - 128] = npv[tid - 128];
    conv_tile(qraw, args.in[I_ML_CONV_W] + l * 4 * 1024 + h * 128, 1024, args.in[I_ML_CONV_B] + l * 1024 + h * 128, raw, QC, 1.0f, tid);
    conv_tile(kraw, args.in[I_ML_CONV_W] + l * 4 * 1024 + 512 + h * 128, 1024, args.in[I_ML_CONV_B] + l * 1024 + 512 + h * 128, raw, KC, 0.08838834764831845f, tid);
#pragma unroll
    for (int i = 0; i < 4; ++i) { const int idx = tid + NTHREADS * i, s = idx >> 4, ck = idx & 15; *(LAS u32x4*)(VT + s * TS + 8 * ck) = vraw[i]; }
#pragma unroll
    for (int i = 0; i < 4; ++i) { const int idx = tid + NTHREADS * i; *(LAS u32x4*)(raw + (idx >> 4) * TS + 8 * (idx & 15)) = cpr[i]; }
    __syncthreads();
    const int tl = 16 * w + fr;
    bf16x8 qf[4];
#pragma unroll
    for (int ks = 0; ks < 4; ++ks) qf[ks] = *(const LAS bf16x8*)(QC + tl * TS + 32 * ks + 8 * fq);
    float pv[8][4]; float rs = 0.f; const float bt = bcl[tl] - mtl[tl];
#pragma unroll
    for (int nb = 0; nb < 8; ++nb) { f32x4 s4 = (f32x4){0.f, 0.f, 0.f, 0.f};
        if (nb <= w) {
#pragma unroll
            for (int ks = 0; ks < 4; ++ks) { const bf16x8 cf = *(const LAS bf16x8*)(KC + (16 * nb + fr) * TS + 32 * ks + 8 * fq); s4 = MFMA16(cf, qf[ks], s4); }
            const f32x4 g4 = *(const LAS f32x4*)(gil + 16 * nb + 4 * fq);
#pragma unroll
            for (int j = 0; j < 4; ++j) { const int s = 16 * nb + 4 * fq + j; const float p = (s <= tl) ? s4[j] * __expf(bt + g4[j]) : 0.f; pv[nb][j] = p; rs += p; }
        } else {
#pragma unroll
            for (int j = 0; j < 4; ++j) pv[nb][j] = 0.f; } }
    rs += __shfl_xor(rs, 16); rs += __shfl_xor(rs, 32);
    f32x4 n1[8], n2[8];
#pragma unroll
    for (int db = 0; db < 8; ++db) { n1[db] = (f32x4){0.f, 0.f, 0.f, 0.f}; n2[db] = (f32x4){0.f, 0.f, 0.f, 0.f}; }
#pragma unroll
    for (int ksv = 0; ksv < 4; ++ksv) if (2 * ksv <= w) { u32x4 pw; pw.x = cvt_pk_bf16(pv[2 * ksv][0], pv[2 * ksv][1]); pw.y = cvt_pk_bf16(pv[2 * ksv][2], pv[2 * ksv][3]);
        pw.z = cvt_pk_bf16(pv[2 * ksv + 1][0], pv[2 * ksv + 1][1]); pw.w = cvt_pk_bf16(pv[2 * ksv + 1][2], pv[2 * ksv + 1][3]);
        const bf16x8 rf = __builtin_bit_cast(bf16x8, pw);
#pragma unroll
        for (int db = 0; db < 8; ++db) { const bf16x8 cf = tr_frag(VT, 32 * ksv + 4 * fq, 32 * ksv + 16 + 4 * fq, 16 * db, lane); n1[db] = MFMA16(cf, rf, n1[db]); } }
#pragma unroll
    for (int ks = 0; ks < 4; ++ks)
#pragma unroll
        for (int db = 0; db < 8; ++db) { const bf16x8 cf = *(const LAS bf16x8*)(raw + (16 * db + fr) * TS + 32 * ks + 8 * fq); n2[db] = MFMA16(cf, qf[ks], n2[db]); }
    float d2 = 0.f;
#pragma unroll
    for (int ks = 0; ks < 4; ++ks) { float x[8]; unpack8(__builtin_bit_cast(u32x4, qf[ks]), x); const f32x4 a0 = *(const LAS f32x4*)(npl + 32 * ks + 8 * fq), a1 = *(const LAS f32x4*)(npl + 32 * ks + 8 * fq + 4);
#pragma unroll
        for (int e = 0; e < 4; ++e) d2 += x[e] * a0[e] + x[4 + e] * a1[e]; }
    d2 += __shfl_xor(d2, 16); d2 += __shfl_xor(d2, 32);
    const float sct = scl[tl]; const float den = rs + sct * d2; const float dnm = fmaxf(fabsf(den), __expf(-mtl[tl])); const float inv = 1.0f / dnm;
    float ss = 0.f;
#pragma unroll
    for (int db = 0; db < 8; ++db)
#pragma unroll
        for (int j = 0; j < 4; ++j) { const float hv = (n1[db][j] + sct * n2[db][j]) * inv; n1[db][j] = hv; ss += hv * hv; }
    ss += __shfl_xor(ss, 16); ss += __shfl_xor(ss, 32);
    const float rstd = rsqrtf(ss * (1.0f / 128.0f) + EPS);
    const float* g_h = args.in[I_ML_NORM_H] + l * 512 + h * 128; const size_t row = (size_t)t0 + tl;
#pragma unroll
    for (int db = 0; db < 8; ++db) { const int v = 16 * db + 4 * fq; const f32x4 gh = *(const f32x4*)(g_h + v); const u32x2 ow = opre[db];
        u32x2 ov; ov.x = cvt_pk_bf16(sigmoidf_(bflo(ow.x)) * n1[db][0] * rstd * gh[0], sigmoidf_(bfhi(ow.x)) * n1[db][1] * rstd * gh[1]);
        ov.y = cvt_pk_bf16(sigmoidf_(bflo(ow.y)) * n1[db][2] * rstd * gh[2], sigmoidf_(bfhi(ow.y)) * n1[db][3] * rstd * gh[3]);
        *(u32x2*)(y + row * DM + 1024 + h * 128 + v) = ov; }
    __syncthreads();
}
#ifndef REP_U1
#define REP_U1 1
#endif
#ifndef REP_U2
#define REP_U2 1
#endif
#ifndef REP_U3
#define REP_U3 1
#endif
#define MIX_PRE() int l = l_; asm volatile("" : "+s"(l)); int tid_m = threadIdx.x; asm volatile("" : "+v"(tid_m))
#define MIXER_PHASE_1 do { MIX_PRE(); \
    TP_BEGIN(11); for (int r_ = 0; r_ < REP_U1; ++r_) for (int u = vb; u < 256; u += G) mix_ml1(args, l, lds, u, tid_m); TP_END(11); \
    TP_BEGIN(12); for (int r_ = 0; r_ < REP_U2; ++r_) for (int u = vb; u < 256; u += G) mix_lru0(args, l, lds, u, tid_m); TP_END(12); \
    TP_BEGIN(13); for (int r_ = 0; r_ < REP_U3; ++r_) for (int u = vb; u < 256; u += G) mix_gmlp(args, l, lds, u, tid_m); TP_END(13); \
  } while (0)
#define MIXER_PHASE_2 do { MIX_PRE(); \
    TP_BEGIN(14); for (int u = vb; u < 256; u += G) mix_ml2(args, lds, u, tid_m); TP_END(14); \
    TP_BEGIN(15); for (int u = vb; u < 256; u += G) mix_attn(args, l, lds, u, tid_m); TP_END(15); \
    for (int u = vb; u < 256; u += G) mix_lru1(args, l, lds, u, tid_m); \
  } while (0)
#define MIXER_PHASE_3 do { MIX_PRE(); \
    for (int u = vb; u < 256; u += G) mix_ml3(args, l, lds, u, tid_m); \
  } while (0)
#ifndef PH_EN_P
#define PH_EN_P 1
#endif
#ifndef PH_EN_A
#define PH_EN_A 1
#endif
#ifndef PH_EN_C
#define PH_EN_C 1
#endif
#ifndef PH_EN_D
#define PH_EN_D 1
#endif
#ifndef PH_EN_E
#define PH_EN_E 1
#endif
#ifndef PH_EN_F
#define PH_EN_F 1
#endif
#ifndef XCC_LOCAL_SEAMS
#define XCC_LOCAL_SEAMS 1
#endif
__device__ __forceinline__ void xcc_local_barrier(unsigned* ctl, unsigned x, unsigned nloc, unsigned* nbw = nullptr, unsigned need = 0u) {
    asm volatile("s_waitcnt vmcnt(0)" ::: "memory");
    __syncthreads();
    if (threadIdx.x == 0) {
        __builtin_amdgcn_s_waitcnt(0);
        const unsigned old = xb_add(&ctl[12288 + 64 * x], 1u), gen = old / nloc;
        if (old + 1u == (gen + 1u) * nloc) { if (nbw) XB_SPIN(xb_ld(nbw) < need, ctl + 4096); xb_add(&ctl[13312 + 64 * x], 1u); }
        else XB_SPIN(xb_ld(&ctl[13312 + 64 * x]) == gen, ctl + 4096);
        __builtin_amdgcn_fence(__ATOMIC_ACQUIRE, "agent");
        asm volatile("s_waitcnt vmcnt(0)" ::: "memory");
    }
    __syncthreads();
}
constexpr int N_PHASES = 1 + 8 * DEPTH;
__global__ void __launch_bounds__(NTHREADS, 2) mk_fwd(Args args) {
    extern __shared__ __attribute__((aligned(16))) unsigned char lds_raw[];
    LAS unsigned char* lds = (LAS unsigned char*)lds_raw;
    const int tid = threadIdx.x, lane = tid & 63, wave = __builtin_amdgcn_readfirstlane(tid >> 6);
    const int G = gridDim.x; const int bx = blockIdx.x; const int vcu = (G % 8 == 0) ? (bx % 8) * (G / 8) + bx / 8 : bx;
    if (tid < 16) ((LAS unsigned*)(lds + LDS_MISC))[tid] = 0u;
    __syncthreads();
    unsigned* barw = (unsigned*)(args.ws + WS_CTL) + 4096;
    XcdBarrier bar = xcd_barrier_post(barw, (volatile LAS unsigned*)(lds + LDS_MISC));
    unsigned* ctlw = (unsigned*)(args.ws + WS_CTL);
    if (tid == 0) ((volatile LAS unsigned*)(lds + LDS_MISC))[4] = xb_add(&ctlw[10240 + 64 * bar.x], 1u);
    const Args& P = args;
    const int lo = args.ph_lo, hi = args.ph_hi;
#define IN(k) (lo <= (k) && (k) < hi)
#define BOTH(k) (IN(k) && IN((k) + 1))
#define SEAM(k) do { if (BOTH(k)) { TP_BEGIN(9); TP_BEGIN(20 + (((k) + 7) & 7)); xcd_barrier(bar); TP_END(20 + (((k) + 7) & 7)); TP_END(9); } } while (0)
#ifdef TPROBE
    unsigned long long tp_t0 = 0; unsigned tp_sum = 0;
#endif
#if defined(TPROBE) && TPROBE == 30
    if (threadIdx.x == 0) ((unsigned long long*)(args.ws + WS_CTL + 256 * 1024))[blockIdx.x] = __builtin_amdgcn_s_memrealtime();
#endif
    TP_BEGIN(10);
    if (PH_EN_P && IN(0)) { TP_BEGIN(0); for (int rep = 0; rep < REP_P; ++rep) p0_prologue(P, lds, vcu, G, wave, lane); TP_END(0); SEAM(0); }
#define WSP(T, off) ((T*)(wsb + (off)))
#define OPAQUE_WS() size_t opq_ = 0; asm volatile("" : "+s"(opq_)); unsigned char* wsb = args.ws + opq_; int l = l_; asm volatile("" : "+s"(l)); unsigned char* wl = wsb + WS_W + (size_t)l * WL_STRIDE
    int cid = bx; bool xcc_ok = false;
    if (BOTH(0)) {
        if (tid == 0) { bool ok = (G == 256);
            for (unsigned j = 0; j < 16; ++j) { const unsigned cnt = xb_ld(&ctlw[10240 + 64 * j]); ok = ok && (cnt == (j < 8 ? 32u : 0u)); }
            ((volatile LAS unsigned*)(lds + LDS_MISC))[5] = ok ? 1u : 0u; }
        __syncthreads();
        xcc_ok = ((volatile LAS unsigned*)(lds + LDS_MISC))[5] != 0u;
        if (xcc_ok) cid = (int)(((volatile LAS unsigned*)(lds + LDS_MISC))[4] * 8u + bar.x);
    }
    cid = __builtin_amdgcn_readfirstlane(cid);
    int vb = xcc_ok ? ((cid & 7) * 32 + (cid >> 3)) : bx; vb = __builtin_amdgcn_readfirstlane(vb);
#define SEAM_L(k) do { if (BOTH(k)) { TP_BEGIN(9); if (xcc_ok && XCC_LOCAL_SEAMS) xcc_local_barrier(ctlw, bar.x, 32u); else xcd_barrier(bar); TP_END(9); } } while (0)
#define SEAM_LG(k, need) do { if (BOTH(k)) { TP_BEGIN(9); if (xcc_ok && XCC_LOCAL_SEAMS) xcc_local_barrier(ctlw, bar.x, 32u, bar.x < 7u ? &ctlw[13312 + 64 * (bar.x + 1u)] : nullptr, (need)); else xcd_barrier(bar); TP_END(9); } } while (0)
    for (int l_ = 0; l_ < DEPTH; ++l_) {
        const int pb = 1 + 8 * l_;
        if (PH_EN_A && IN(pb + 0)) {
            TP_BEGIN(1); OPAQUE_WS();
            pg8::Gemm g{WSP(bf16_t, WS_XB), (const bf16_t*)(wl + WL_A), SEQ, NA, DM}; GEMM_ORDER S; S.init(SEQ, NA, G, cid);
            EpiA E{WSP(float, WS_STATS), WSP(bf16_t, WS_PROJ), WSP(float, WS_IFG), WSP(unsigned char, WS_GATES), args.in[I_B_GATE] + (size_t)l * 4 * DM, WSP(float, WS_GVS)};
            for (int rep = 0; rep < REP_A; ++rep) pg8::gemm_phase<EpiA, GEMM_ORDER>(lds, g, S, E);
            if (l + 1 < DEPTH && bx >= 224) { int ln = threadIdx.x & 63; asm volatile("" : "+v"(ln)); cvt_tail(args, l + 1, CV_TAIL_E, 32 * NWAVES, CV_A_PW, (bx - 224) * NWAVES + wave, lds, wave, ln); }
            TP_END(1); SEAM(pb + 0);
        }
        if (IN(pb + 1)) { TP_BEGIN(2); for (int rep = 0; rep < REP_M1; ++rep) { MIXER_PHASE_1; } TP_END(2); SEAM(pb + 1); }
        if (IN(pb + 2)) { TP_BEGIN(3); for (int rep = 0; rep < REP_M2; ++rep) { MIXER_PHASE_2; } TP_END(3); SEAM(pb + 2); }
        if (IN(pb + 3)) { TP_BEGIN(4); for (int rep = 0; rep < REP_M3; ++rep) { MIXER_PHASE_3; } TP_END(4); SEAM_L(pb + 3); }
        if (PH_EN_C && IN(pb + 4)) {
            TP_BEGIN(5); OPAQUE_WS();
            pg8::Gemm g{WSP(bf16_t, WS_Y), (const bf16_t*)(wl + WL_C), SEQ, DM, DM}; GEMM_ORDER S; S.init(SEQ, DM, G, cid);
            EpiC E{WSP(unsigned char, WS_GATES), WSP(bf16_t, WS_MERGED)};
            for (int rep = 0; rep < REP_C; ++rep) pg8::gemm_phase<EpiC, GEMM_ORDER>(lds, g, S, E);
            TP_END(5); SEAM_L(pb + 4);
        }
        if (PH_EN_D && IN(pb + 5)) {
            TP_BEGIN(6); OPAQUE_WS();
            pg8::Gemm g{WSP(bf16_t, WS_MERGED), (const bf16_t*)(wl + WL_D), SEQ, DM, DM}; GEMM_ORDER S; S.init(SEQ, DM, G, cid);
#ifdef REP_D
            { EpiD<false> E2{WSP(bf16_t, WS_XB), WSP(float, WS_ML + 28 * MiB), nullptr, WSP(bf16_t, WS_NAIVE + 32 * MiB)}; pg8::gemm_phase<EpiD<false>, GEMM_ORDER>(lds, g, S, E2); }
#endif
            EpiD<false> E{WSP(bf16_t, WS_XB), WSP(float, WS_STATS) + (size_t)SEQ * 32, nullptr, WSP(bf16_t, WS_XB)};
            pg8::gemm_phase<EpiD<false>, GEMM_ORDER>(lds, g, S, E);
            TP_END(6); SEAM_LG(pb + 5, 5u * (unsigned)l_ + 1u);
        }
        if (PH_EN_E && IN(pb + 6)) {
            TP_BEGIN(7); OPAQUE_WS();
            pg8::Gemm g{WSP(bf16_t, WS_XB), (const bf16_t*)(wl + WL_E), SEQ, 2 * FF, DM}; E_ORDER S; S.init(SEQ, 2 * FF, G, cid);
            EpiE E{WSP(float, WS_STATS) + (size_t)SEQ * 32, WSP(bf16_t, WS_H)};
            for (int rep = 0; rep < REP_E; ++rep) pg8::gemm_phase<EpiE, E_ORDER>(lds, g, S, E);
            if (l + 1 < DEPTH && bx >= 128) { int ln = threadIdx.x & 63; asm volatile("" : "+v"(ln)); cvt_tail(args, l + 1, 0, 128 * NWAVES, CV_E_PW, (bx - 128) * NWAVES + wave, lds, wave, ln); }
            TP_END(7); SEAM_L(pb + 6);
        }
        if (PH_EN_F && IN(pb + 7)) {
            TP_BEGIN(8); OPAQUE_WS();
            pg8::Gemm g{WSP(bf16_t, WS_H), (const bf16_t*)(wl + WL_F), SEQ, DM, FF}; GEMM_ORDER S; S.init(SEQ, DM, G, cid);
#ifdef REP_F
            { EpiD<false> E2{WSP(bf16_t, WS_XB), WSP(float, WS_ML + 28 * MiB), nullptr, WSP(bf16_t, WS_NAIVE + 32 * MiB)}; pg8::gemm_phase<EpiD<false>, GEMM_ORDER>(lds, g, S, E2); }
#endif
            if (l + 1 < DEPTH) { EpiD<false> E{WSP(bf16_t, WS_XB), WSP(float, WS_STATS), nullptr, WSP(bf16_t, WS_XB)}; pg8::gemm_phase<EpiD<false>, GEMM_ORDER>(lds, g, S, E); }
            else { EpiD<true> E{WSP(bf16_t, WS_XB), nullptr, args.out, nullptr}; pg8::gemm_phase<EpiD<true>, GEMM_ORDER>(lds, g, S, E); }
            TP_END(8); if (l_ + 1 < DEPTH) SEAM_L(pb + 7);
        }
    }
#ifdef TPROBE
    TP_END(10);
    xcd_barrier(bar);
#if TPROBE == 30
    if (blockIdx.x == 0 && threadIdx.x == 0) { const unsigned long long* st = (const unsigned long long*)(args.ws + WS_CTL + 256 * 1024); unsigned long long lo = ~0ull, hi = 0ull;
        for (int b = 0; b < (int)gridDim.x; ++b) { const unsigned long long v = __hip_atomic_load(st + b, __ATOMIC_RELAXED, __HIP_MEMORY_SCOPE_AGENT); lo = v < lo ? v : lo; hi = v > hi ? v : hi; }
        tp_sum = (unsigned)(hi - lo); }
#endif
    if (blockIdx.x == 0 && threadIdx.x == 0) args.out[0] += ((float)tp_sum * 0.01f - (float)TP_OFF) * 0.01f;
#endif
#undef IN
#undef BOTH
#undef SEAM
#undef SEAM_L
#undef SEAM_LG
}

extern "C" void kernel_launch(void* const* d_in, const int* in_sizes, int n_in, void* d_out, int out_size, void* d_ws, size_t ws_size, hipStream_t stream) {
    static int grid = 0;
    if (grid == 0) {
        if (n_in != N_IN || in_sizes[0] != SEQ * DM || out_size != SEQ * DM || ws_size < WS_END) {
            fprintf(stderr, "kernel_launch: unexpected shapes (n_in %d, in0 %d, out %d, ws %zu < %zu); nothing launched\n", n_in, n_in > 0 ? in_sizes[0] : -1, out_size, ws_size, (size_t)WS_END); grid = -1; return; }
        int dev = 0, cus = 0;
        if (hipGetDevice(&dev) != hipSuccess || hipDeviceGetAttribute(&cus, hipDeviceAttributeMultiprocessorCount, dev) != hipSuccess) { grid = -1; return; }
        if (hipFuncSetAttribute((const void*)mk_fwd, hipFuncAttributeMaxDynamicSharedMemorySize, LDS_BYTES) != hipSuccess) { fprintf(stderr, "kernel_launch: hipFuncSetAttribute failed\n"); grid = -1; return; }
        int per_cu = 0;
        if (hipOccupancyMaxActiveBlocksPerMultiprocessor(&per_cu, (const void*)mk_fwd, NTHREADS, LDS_BYTES) != hipSuccess || per_cu < 1) { fprintf(stderr, "kernel_launch: occupancy query says %d\n", per_cu); }
        (void)hipGetLastError();
        grid = cus;
    }
    if (grid < 0) return;
    (void)hipMemsetAsync((char*)d_ws + WS_CTL, 0, 64 * 1024, stream);
    Args a{};
    for (int i = 0; i < N_IN; ++i) a.in[i] = (const float*)d_in[i];
    a.out = (float*)d_out; a.ws = (unsigned char*)d_ws;
    auto launch = [&](int lo, int hi, int flags = 0) { a.ph_lo = lo; a.ph_hi = hi; a.flags = flags; hipLaunchKernelGGL(mk_fwd, dim3(grid), dim3(NTHREADS), LDS_BYTES, stream, a); };
    unsigned char* ws = (unsigned char*)d_ws;
    const bf16_t* proj = (const bf16_t*)(ws + WS_PROJ); bf16_t* y = (bf16_t*)(ws + WS_Y); const float* ifg = (const float*)(ws + WS_IFG);
    float* XC = (float*)(ws + WS_NAIVE); float* NA_ = (float*)(ws + WS_NAIVE + 16 * MiB); float* NBX = (float*)(ws + WS_NAIVE + 32 * MiB);
    float* QK = (float*)(ws + WS_NAIVE); float* NF = (float*)(ws + WS_NAIVE + 48 * MiB); float* NG_ = (float*)(ws + WS_NAIVE + 49 * MiB);
    launch(0, N_PHASES, 15);
}
```
